# Optimizing an MI355X kernel written in HIP

```python
import math
import jax
import jax.numpy as jnp
from jax import lax
import numpy as np

D_MODEL = 1024
BATCH = 32
SEQ = 256
DEPTH = 4
DEC_BATCH = 8
DEC_SEQ = 4096
PAST_LEN = 512

GRID_W = 64
GLA_HEADS = 4
GLA_KEY = D_MODEL // 2
GLA_VAL = D_MODEL
GLA_DK = GLA_KEY // GLA_HEADS
GLA_DV = GLA_VAL // GLA_HEADS
GATE_RANK = 16
GLA_TAU = 16.0
GLA_CHUNK = 64
S5_WIDTH = D_MODEL
S5_GROUP = 16
S5_GROUPS = S5_WIDTH // S5_GROUP
S5_STATE = 64
S5_CHUNK = 128
LRU_WIDTH = 3 * D_MODEL // 2
LRU_BLOCK = 128
LRU_BLOCKS = LRU_WIDTH // LRU_BLOCK
LRU_CONV = 4
LRU_C = 8.0
MLP_HIDDEN = 4 * D_MODEL
ALPHA = (2.0 * DEPTH) ** 0.25
BETA = (8.0 * DEPTH) ** -0.25
IN_WIDTHS = (GLA_KEY, GLA_KEY, GLA_VAL, GLA_VAL, 2 * GATE_RANK, S5_WIDTH, LRU_WIDTH, LRU_WIDTH, 3 * D_MODEL)
IN_COLS = sum(IN_WIDTHS)

kernel_name = "hybrid_gla_s5_rglru_flow_step"

F32 = jnp.float32


def _flip(z):
    return jnp.flip(z, axis=1)


def _in_splits():
    return tuple(int(i) for i in np.cumsum(IN_WIDTHS)[:-1])


def layer_norm(x, g, b, eps=1e-5):
    xf = x.astype(F32)
    mu = jnp.mean(xf, axis=-1, keepdims=True)
    var = jnp.mean(jnp.square(xf - mu), axis=-1, keepdims=True)
    y = (xf - mu) * lax.rsqrt(var + eps)
    return (y * g.astype(F32) + b.astype(F32)).astype(x.dtype)


def grid_pos_embed(n_tokens, dim):
    rows = n_tokens // GRID_W
    quarter = dim // 4
    omega = 1.0 / (10000.0 ** (jnp.arange(quarter, dtype=F32) / quarter))
    r = jnp.arange(rows, dtype=F32)[:, None, None] * omega
    cl = jnp.arange(GRID_W, dtype=F32)[None, :, None] * omega
    shape = (rows, GRID_W, quarter)
    emb = jnp.concatenate([jnp.broadcast_to(jnp.sin(r), shape), jnp.broadcast_to(jnp.cos(r), shape),
                           jnp.broadcast_to(jnp.sin(cl), shape), jnp.broadcast_to(jnp.cos(cl), shape)], axis=-1)
    return emb.reshape(rows * GRID_W, dim)


def gla_scan(q, k, v, log_a, s0):
    bsz, T, H, DK = q.shape
    DV = v.shape[-1]
    n = T // GLA_CHUNK

    def chunks(z):
        return z.reshape(bsz, n, GLA_CHUNK, H, z.shape[-1])

    q, k, v, log_a = chunks(q), chunks(k), chunks(v), chunks(log_a)
    cum = jnp.cumsum(log_a, axis=2)
    last = cum[:, :, -1:]
    q_dec = q * jnp.exp(cum)
    k_inv = k * jnp.exp(-cum)
    k_end = k * jnp.exp(last - cum)
    mask = jnp.tril(jnp.ones((GLA_CHUNK, GLA_CHUNK), dtype=bool))
    scores = jnp.where(mask, jnp.einsum("bnthk,bnshk->bnhts", q_dec, k_inv), 0.0)
    o_intra = jnp.einsum("bnhts,bnshv->bnthv", scores, v)
    upd = jnp.einsum("bnshk,bnshv->nbhkv", k_end, v)
    decay = jnp.exp(jnp.moveaxis(last[:, :, 0], 1, 0))

    def step(S, inp):
        d, u = inp
        return d[..., None] * S + u, S

    s_fin, s_start = lax.scan(step, s0, (decay, upd))
    o_inter = jnp.einsum("bnthk,nbhkv->bnthv", q_dec, s_start)
    return (o_intra + o_inter).reshape(bsz, T, H, DV), s_fin


def _complex_combine(e1, e2):
    a1r, a1i, b1r, b1i = e1
    a2r, a2i, b2r, b2i = e2
    return (a2r * a1r - a2i * a1i, a2r * a1i + a2i * a1r,
            a2r * b1r - a2i * b1i + b2r, a2r * b1i + a2i * b1r + b2i)


def _real_combine(e1, e2):
    return (e1[0] * e2[0], e2[0] * e1[1] + e2[1])


def s5_scan(u, lam_re, lam_im, log_step, b_re, b_im, c_re, c_im, s_re0, s_im0):
    bsz, T, G, I = u.shape
    n = T // S5_CHUNK
    step = jnp.exp(log_step)[:, None]
    mag = jnp.exp(lam_re * step)
    ang = lam_im * step
    ab_re, ab_im = mag * jnp.cos(ang), mag * jnp.sin(ang)
    den = jnp.square(lam_re) + jnp.square(lam_im)
    nr = ab_re - 1.0
    f_re = (nr * lam_re + ab_im * lam_im) / den
    f_im = (ab_im * lam_re - nr * lam_im) / den
    bb_re = f_re[..., None] * b_re - f_im[..., None] * b_im
    bb_im = f_re[..., None] * b_im + f_im[..., None] * b_re
    u_chunks = jnp.moveaxis(u.reshape(bsz, n, S5_CHUNK, G, I), 1, 0)

    def chunk_step(carry, u_c):
        s_re, s_im = carry
        x_re = jnp.einsum("bcgi,gpi->bcgp", u_c, bb_re)
        x_im = jnp.einsum("bcgi,gpi->bcgp", u_c, bb_im)
        x_re = x_re.at[:, 0].add(ab_re * s_re - ab_im * s_im)
        x_im = x_im.at[:, 0].add(ab_re * s_im + ab_im * s_re)
        a_re = jnp.broadcast_to(ab_re, x_re.shape)
        a_im = jnp.broadcast_to(ab_im, x_im.shape)
        _, _, h_re, h_im = lax.associative_scan(_complex_combine, (a_re, a_im, x_re, x_im), axis=1)
        y = jnp.einsum("bcgp,gip->bcgi", h_re, c_re) - jnp.einsum("bcgp,gip->bcgi", h_im, c_im)
        return (h_re[:, -1], h_im[:, -1]), y

    (s_re, s_im), ys = lax.scan(chunk_step, (s_re0, s_im0), u_chunks)
    return jnp.moveaxis(ys, 0, 1).reshape(bsz, T, G, I), s_re, s_im


def rglru_scan(x, gate_a, gate_i, lam, h0):
    log_a = -LRU_C * jax.nn.softplus(-lam) * jax.nn.sigmoid(gate_a)
    a = jnp.exp(log_a)
    b = jnp.sqrt(-jnp.expm1(2.0 * log_a)) * (jax.nn.sigmoid(gate_i) * x)
    b = b.at[:, 0].add(a[:, 0] * h0)
    _, h = lax.associative_scan(_real_combine, (a, b), axis=1)
    return h, h[:, -1]


def centred_depthwise_conv(x, w, bias):
    T = x.shape[1]
    left = LRU_CONV // 2
    right = LRU_CONV - 1 - left
    xp = jnp.pad(x, ((0, 0), (left, right), (0, 0)))
    return bias + sum(w[j] * xp[:, j:j + T] for j in range(LRU_CONV))


def mixer(h, lw, init):
    gla0, s5re0, s5im0, lru0 = [s.astype(F32) for s in init]
    bsz, T, _ = h.shape
    dt = h.dtype
    proj = h @ lw["w_in"]
    q, k, v, r, glr, u, lx, ly, gates = jnp.split(proj, _in_splits(), axis=-1)

    qh = q.astype(F32).reshape(bsz, T, GLA_HEADS, GLA_DK) * (GLA_DK ** -0.5)
    kh = k.astype(F32).reshape(bsz, T, GLA_HEADS, GLA_DK)
    vh = v.astype(F32).reshape(bsz, T, GLA_HEADS, GLA_DV)
    logits = jnp.einsum("bter,erk->btek", glr.astype(F32).reshape(bsz, T, 2, GATE_RANK),
                        lw["gla_w_gate"].astype(F32)) + lw["gla_b_gate"].astype(F32)
    log_a = (jax.nn.log_sigmoid(logits) / GLA_TAU).reshape(bsz, T, 2, GLA_HEADS, GLA_DK)
    o_f, sg_f = gla_scan(qh, kh, vh, log_a[:, :, 0], gla0[:, 0])
    o_b, sg_b = gla_scan(_flip(qh), _flip(kh), _flip(vh), _flip(log_a[:, :, 1]), gla0[:, 1])
    o = o_f + _flip(o_b)
    mu = jnp.mean(o, axis=-1, keepdims=True)
    var = jnp.mean(jnp.square(o - mu), axis=-1, keepdims=True)
    on = ((o - mu) * lax.rsqrt(var + 1e-5)).reshape(bsz, T, GLA_VAL)
    y_gla = (on * lw["gla_norm_g"].astype(F32) * jax.nn.silu(r.astype(F32))).astype(dt)

    uf = u.astype(F32)
    ug = uf.reshape(bsz, T, S5_GROUPS, S5_GROUP)
    s5p = [lw[nm].astype(F32) for nm in ("s5_b_re", "s5_b_im", "s5_c_re", "s5_c_im")]
    lam_re = lw["s5_lam_re"].astype(F32)
    lam_im = lw["s5_lam_im"].astype(F32)
    log_step = lw["s5_log_step"].astype(F32)
    ys_f, sr_f, si_f = s5_scan(ug, lam_re[0], lam_im[0], log_step[0], *s5p, s5re0[:, 0], s5im0[:, 0])
    ys_b, sr_b, si_b = s5_scan(_flip(ug), lam_re[1], lam_im[1], log_step[1], *s5p, s5re0[:, 1], s5im0[:, 1])
    ys = (ys_f + _flip(ys_b)).reshape(bsz, T, S5_WIDTH) + lw["s5_d"].astype(F32) * uf
    ys = jax.nn.gelu(ys).astype(dt)
    y_s5 = ys * jax.nn.sigmoid(ys @ lw["s5_w_glu"])

    xc = centred_depthwise_conv(lx, lw["lru_conv_w"], lw["lru_conv_b"]).astype(F32)
    xb = xc.reshape(bsz, T, LRU_BLOCKS, LRU_BLOCK)
    ga = jnp.einsum("btnc,encd->btend", xb, lw["lru_w_a"].astype(F32)).reshape(bsz, T, 2, LRU_WIDTH) \
        + lw["lru_b_a"].astype(F32)
    gi = jnp.einsum("btnc,encd->btend", xb, lw["lru_w_i"].astype(F32)).reshape(bsz, T, 2, LRU_WIDTH) \
        + lw["lru_b_i"].astype(F32)
    lam = lw["lru_lam"].astype(F32)
    hf, lf = rglru_scan(xc, ga[:, :, 0], gi[:, :, 0], lam[0], lru0[:, 0])
    hb, lb = rglru_scan(_flip(xc), _flip(ga[:, :, 1]), _flip(gi[:, :, 1]), lam[1], lru0[:, 1])
    y_lru = ((hf + _flip(hb)) * jax.nn.gelu(ly.astype(F32))).astype(dt)

    g_gla, g_s5, g_lru = jnp.split(jax.nn.sigmoid(gates), 3, axis=-1)
    merged = (g_gla * (y_gla @ lw["w_br_gla"]) + g_s5 * (y_s5 @ lw["w_br_s5"])
              + g_lru * (y_lru @ lw["w_br_lru"]))
    out = merged @ lw["w_out"]
    finals = (jnp.stack([sg_f, sg_b], axis=1), jnp.stack([sr_f, sr_b], axis=1),
              jnp.stack([si_f, si_b], axis=1), jnp.stack([lf, lb], axis=1))
    return out, finals


def trunk_layer(x, mod, lw, init):
    shift1, scale1, gate1, shift2, scale2, gate2 = jnp.split(mod[:, None, :], 6, axis=-1)
    mix, finals = mixer(x * (1 + scale1) + shift1, lw, init)
    x = layer_norm(ALPHA * x + gate1 * mix, lw["ln1_g"], lw["ln1_b"])
    hid = jnp.square(jax.nn.relu((x * (1 + scale2) + shift2) @ lw["w_mlp_in"]))
    x = layer_norm(ALPHA * x + gate2 * (hid @ lw["w_mlp_out"]), lw["ln2_g"], lw["ln2_b"])
    return x, finals


def setup_inputs(seed: int = 0) -> dict:
    key = jax.random.key(seed)
    ks = iter(jax.random.split(key, 64))
    L, D = DEPTH, D_MODEL

    def nrm(shape, scale):
        return scale * jax.random.normal(next(ks), shape, F32)

    def unif(shape, lo, hi):
        return jax.random.uniform(next(ks), shape, F32, lo, hi)

    lru_a8 = unif((L, 2, LRU_WIDTH), 0.9, 0.999)
    lru_s = lru_a8 ** (1.0 / LRU_C)
    inp = {}
    inp["x_prompt"] = nrm((BATCH, SEQ, D), 1.0)
    inp["x_sample"] = nrm((DEC_BATCH, DEC_SEQ, D), 1.0)
    inp["state_gla"] = nrm((DEC_BATCH, L, 2, GLA_HEADS, GLA_DK, GLA_DV), 1.0)
    inp["state_s5_re"] = nrm((DEC_BATCH, L, 2, S5_GROUPS, S5_STATE), 0.1)
    inp["state_s5_im"] = nrm((DEC_BATCH, L, 2, S5_GROUPS, S5_STATE), 0.1)
    inp["state_lru"] = nrm((DEC_BATCH, L, 2, LRU_WIDTH), 0.5)
    inp["c"] = nrm((DEC_BATCH, D), 1.0)
    inp["c_ctx"] = nrm((D,), 1.0)
    inp["w_ada"] = nrm((L, D, 6 * D), 0.5 * D ** -0.5)
    inp["b_ada"] = nrm((L, 6 * D), 0.02)
    inp["w_in"] = nrm((L, D, IN_COLS), D ** -0.5)
    inp["gla_w_gate"] = nrm((L, 2, GATE_RANK, GLA_KEY), GATE_RANK ** -0.5)
    inp["gla_b_gate"] = nrm((L, 2, GLA_KEY), 0.1)
    inp["gla_norm_g"] = 1.0 + nrm((L, GLA_VAL), 0.02)
    inp["s5_lam_re"] = -0.5 + nrm((L, 2, S5_GROUPS, S5_STATE), 0.01)
    inp["s5_lam_im"] = jnp.pi * jnp.arange(S5_STATE, dtype=F32) + nrm((L, 2, S5_GROUPS, S5_STATE), 0.01)
    inp["s5_log_step"] = unif((L, 2, S5_GROUPS), math.log(0.001), math.log(0.1))
    inp["s5_b_re"] = nrm((L, S5_GROUPS, S5_STATE, S5_GROUP), (2 * S5_GROUP) ** -0.5)
    inp["s5_b_im"] = nrm((L, S5_GROUPS, S5_STATE, S5_GROUP), (2 * S5_GROUP) ** -0.5)
    inp["s5_c_re"] = nrm((L, S5_GROUPS, S5_GROUP, S5_STATE), S5_STATE ** -0.5)
    inp["s5_c_im"] = nrm((L, S5_GROUPS, S5_GROUP, S5_STATE), S5_STATE ** -0.5)
    inp["s5_d"] = nrm((L, S5_WIDTH), 1.0)
    inp["s5_w_glu"] = nrm((L, S5_WIDTH, S5_WIDTH), S5_WIDTH ** -0.5)
    inp["lru_conv_w"] = nrm((L, LRU_CONV, LRU_WIDTH), LRU_CONV ** -0.5)
    inp["lru_conv_b"] = nrm((L, LRU_WIDTH), 0.02)
    inp["lru_w_a"] = nrm((L, 2, LRU_BLOCKS, LRU_BLOCK, LRU_BLOCK), LRU_BLOCK ** -0.5)
    inp["lru_b_a"] = nrm((L, 2, LRU_WIDTH), 0.1)
    inp["lru_w_i"] = nrm((L, 2, LRU_BLOCKS, LRU_BLOCK, LRU_BLOCK), LRU_BLOCK ** -0.5)
    inp["lru_b_i"] = nrm((L, 2, LRU_WIDTH), 0.1)
    inp["lru_lam"] = jnp.log(lru_s) - jnp.log1p(-lru_s)
    inp["w_br_gla"] = nrm((L, GLA_VAL, D), GLA_VAL ** -0.5)
    inp["w_br_s5"] = nrm((L, S5_WIDTH, D), S5_WIDTH ** -0.5)
    inp["w_br_lru"] = nrm((L, LRU_WIDTH, D), LRU_WIDTH ** -0.5)
    inp["w_out"] = nrm((L, D, D), BETA * D ** -0.5)
    inp["ln1_g"] = 1.0 + nrm((L, D), 0.02)
    inp["ln1_b"] = nrm((L, D), 0.02)
    inp["ln2_g"] = 1.0 + nrm((L, D), 0.02)
    inp["ln2_b"] = nrm((L, D), 0.02)
    inp["w_mlp_in"] = nrm((L, D, MLP_HIDDEN), D ** -0.5)
    inp["w_mlp_out"] = nrm((L, MLP_HIDDEN, D), BETA * MLP_HIDDEN ** -0.5)
    return inp


def reference(x_prompt, x_sample, state_gla, state_s5_re, state_s5_im, state_lru, c, c_ctx,
              w_ada, b_ada, w_in, gla_w_gate, gla_b_gate, gla_norm_g,
              s5_lam_re, s5_lam_im, s5_log_step, s5_b_re, s5_b_im, s5_c_re, s5_c_im, s5_d, s5_w_glu,
              lru_conv_w, lru_conv_b, lru_w_a, lru_b_a, lru_w_i, lru_b_i, lru_lam,
              w_br_gla, w_br_s5, w_br_lru, w_out, ln1_g, ln1_b, ln2_g, ln2_b, w_mlp_in, w_mlp_out):
    bp = x_prompt.shape[0]
    xp = x_prompt
    xs = x_sample + grid_pos_embed(x_sample.shape[1], D_MODEL).astype(x_sample.dtype)
    silu_ctx = jax.nn.silu(c_ctx)[None]
    silu_c = jax.nn.silu(c)
    zero_init = (jnp.zeros((bp, 2, GLA_HEADS, GLA_DK, GLA_DV), F32),
                 jnp.zeros((bp, 2, S5_GROUPS, S5_STATE), F32),
                 jnp.zeros((bp, 2, S5_GROUPS, S5_STATE), F32),
                 jnp.zeros((bp, 2, LRU_WIDTH), F32))
    fin_gla, fin_s5_re, fin_s5_im, fin_lru = [], [], [], []
    for l in range(DEPTH):
        lw = {"w_in": w_in[l], "gla_w_gate": gla_w_gate[l], "gla_b_gate": gla_b_gate[l],
              "gla_norm_g": gla_norm_g[l], "s5_lam_re": s5_lam_re[l], "s5_lam_im": s5_lam_im[l],
              "s5_log_step": s5_log_step[l], "s5_b_re": s5_b_re[l], "s5_b_im": s5_b_im[l],
              "s5_c_re": s5_c_re[l], "s5_c_im": s5_c_im[l], "s5_d": s5_d[l], "s5_w_glu": s5_w_glu[l],
              "lru_conv_w": lru_conv_w[l], "lru_conv_b": lru_conv_b[l], "lru_w_a": lru_w_a[l],
              "lru_b_a": lru_b_a[l], "lru_w_i": lru_w_i[l], "lru_b_i": lru_b_i[l], "lru_lam": lru_lam[l],
              "w_br_gla": w_br_gla[l], "w_br_s5": w_br_s5[l], "w_br_lru": w_br_lru[l], "w_out": w_out[l],
              "ln1_g": ln1_g[l], "ln1_b": ln1_b[l], "ln2_g": ln2_g[l], "ln2_b": ln2_b[l],
              "w_mlp_in": w_mlp_in[l], "w_mlp_out": w_mlp_out[l]}
        mod_ctx = silu_ctx @ w_ada[l] + b_ada[l]
        xp, fin = trunk_layer(xp, mod_ctx, lw, zero_init)
        fin_gla.append(fin[0])
        fin_s5_re.append(fin[1])
        fin_s5_im.append(fin[2])
        fin_lru.append(fin[3])
        mod_lat = silu_c @ w_ada[l] + b_ada[l]
        cache_l = (state_gla[:, l], state_s5_re[:, l], state_s5_im[:, l], state_lru[:, l])
        xs, _ = trunk_layer(xs, mod_lat, lw, cache_l)
    sdt = x_prompt.dtype
    new_state_gla = jnp.stack(fin_gla, axis=1).astype(sdt)
    new_state_s5_re = jnp.stack(fin_s5_re, axis=1).astype(sdt)
    new_state_s5_im = jnp.stack(fin_s5_im, axis=1).astype(sdt)
    new_state_lru = jnp.stack(fin_lru, axis=1).astype(sdt)
    return (xp, xs, new_state_gla, new_state_s5_re, new_state_s5_im, new_state_lru)
```

```cpp
#include <hip/hip_runtime.h>
#include <hip/hip_cooperative_groups.h>
#include <cstdio>
namespace cg = cooperative_groups;

typedef unsigned short bf16_t;
typedef short bf16x8 __attribute__((ext_vector_type(8)));
typedef float f32x4 __attribute__((ext_vector_type(4)));
typedef unsigned u32x4 __attribute__((ext_vector_type(4)));
typedef unsigned u32x2 __attribute__((ext_vector_type(2)));
#define LAS __attribute__((address_space(3)))

constexpr int D = 1024, SEG = 8192, NSEG = 5, LDP = 10496;
constexpr int CQ = 0, CK = 512, CV = 1024, CR = 2048, CU = 3072, CLX = 4096, CLY = 5632, CG = 7168, CGLR = 10240;
constexpr size_t OUT_GLA = 41943040, OUT_S5RE = OUT_GLA + 33554432, OUT_S5IM = OUT_S5RE + 1048576, OUT_LRU = OUT_S5IM + 1048576;
constexpr float ALPHA = 1.681792830507429f;

constexpr size_t WS_MOD  = 0;
constexpr size_t WS_S5AB = WS_MOD + 4 * 9 * 6144 * 4;
constexpr size_t WS_S5B  = WS_S5AB + 2 * 64 * 64 * 8;
constexpr size_t WS_S5C  = WS_S5B + 2 * 64 * 128 * 16 * 2;
constexpr size_t WS_LCL  = WS_S5C + 64 * 16 * 128 * 2;
constexpr size_t WS_WIN  = WS_LCL + 2 * 1536 * 4;
constexpr size_t WS_WGLU = WS_WIN + (size_t)10496 * 1024 * 2;
constexpr size_t WS_WLRU = WS_WGLU + (size_t)1024 * 1024 * 2;
constexpr size_t WS_WBG  = WS_WLRU + (size_t)6144 * 256 * 2;
constexpr size_t WS_WBS  = WS_WBG + (size_t)1024 * 1024 * 2;
constexpr size_t WS_WBL  = WS_WBS + (size_t)1024 * 1024 * 2;
constexpr size_t WS_WOUT = WS_WBL + (size_t)1024 * 1536 * 2;
constexpr size_t WS_WMI  = WS_WOUT + (size_t)1024 * 1024 * 2;
constexpr size_t WS_WMO  = WS_WMI + (size_t)4096 * 1024 * 2;
constexpr size_t WS_HA   = WS_WMO + (size_t)4096 * 1024 * 2;
constexpr size_t WS_PROJ = WS_HA + (size_t)40960 * 1024 * 2;
constexpr size_t WS_OF   = WS_PROJ + (size_t)SEG * LDP * 2;
constexpr size_t WS_OB   = WS_OF + (size_t)SEG * 1024 * 4;
constexpr size_t WS_YSF  = WS_OB + (size_t)SEG * 1024 * 4;
constexpr size_t WS_YSB  = WS_YSF + (size_t)SEG * 1024 * 2;
constexpr size_t WS_XC   = WS_YSB + (size_t)SEG * 1024 * 2;
constexpr size_t WS_LAB  = WS_XC + (size_t)SEG * 1536 * 2;
constexpr size_t WS_HF   = WS_LAB + (size_t)SEG * 3072 * 4;
constexpr size_t WS_HB   = WS_HF + (size_t)SEG * 1536 * 2;
constexpr size_t WS_YG   = WS_HB + (size_t)SEG * 1536 * 2;
constexpr size_t WS_YSA  = WS_YG + (size_t)SEG * 1024 * 2;
constexpr size_t WS_GST  = WS_YSA + (size_t)SEG * 1024 * 2;
constexpr size_t WS_GLT  = WS_GST + (size_t)256 * 16384 * 4;
constexpr size_t WS_S5E  = WS_GLT + 256 * 128 * 4;
constexpr size_t WS_LRC  = WS_S5E + 256 * 512 * 8;
constexpr size_t WS_MG2  = WS_LRC + 98304 * 8;
constexpr size_t WS_BAR  = WS_MG2 + (size_t)2 * SEG * 1024 * 2;
constexpr size_t WS_END  = WS_BAR + 16384;
constexpr size_t WS_HID = WS_PROJ, WS_MRG = WS_OF, WS_MRG2 = WS_OB, WS_PRE = WS_OF  , WS_YS5 = WS_YSF, WS_YL = WS_XC, WS_H2 = WS_YG, WS_MERGED = WS_YSA;

struct Params { const float* in[40]; float* out; unsigned char* ws; };

typedef __bf16 nbf16x2 __attribute__((ext_vector_type(2)));
typedef float nf32x2 __attribute__((ext_vector_type(2)));
__device__ __forceinline__ bf16_t f2bf(float f) { return __builtin_bit_cast(unsigned short, (__bf16)f); }
__device__ __forceinline__ float bf2f(bf16_t b) { return __uint_as_float(((unsigned)b) << 16); }
__device__ __forceinline__ unsigned pk2(float lo, float hi) { const nf32x2 v = {lo, hi}; return __builtin_bit_cast(unsigned, __builtin_convertvector(v, nbf16x2)); }
__device__ __forceinline__ float bflo(unsigned w) { return __uint_as_float(w << 16); }
__device__ __forceinline__ float bfhi(unsigned w) { return __uint_as_float(w & 0xFFFF0000u); }
__device__ __forceinline__ float sigm(float x) { return __builtin_amdgcn_rcpf(1.f + __expf(-x)); }
__device__ __forceinline__ float tanh_(float x) { float e = __expf(2.f * x); return 1.f - 2.f * __builtin_amdgcn_rcpf(e + 1.f); }
__device__ __forceinline__ float gelu_(float x) { return 0.5f * x * (1.f + tanh_(0.7978845608028654f * (x + 0.044715f * x * x * x))); }
__device__ __forceinline__ float log1p_(float e) { return e < 0.01f ? e * (1.f - e * (0.5f - e * (1.f / 3.f))) : __logf(1.f + e); }
__device__ __forceinline__ float logsig_(float x) { return fminf(x, 0.f) - log1p_(__expf(-fabsf(x))); }
__device__ __forceinline__ float expm1_(float x) { return fabsf(x) < 0.1f ? x * (1.f + x * (0.5f + x * (1.f / 6.f + x * (1.f / 24.f + x * (1.f / 120.f))))) : __expf(x) - 1.f; }
__device__ __forceinline__ float wsum(float v) { for (int o = 32; o > 0; o >>= 1) v += __shfl_xor(v, o); return v; }
__device__ __forceinline__ int otid() { int t = threadIdx.x; asm volatile("" : "+v"(t)); return t; }
__device__ __forceinline__ int ozero() { int z = 0; asm volatile("" : "+s"(z)); return z; }
typedef const float* cfptr;
__device__ __forceinline__ cfptr kin(int i) { const __attribute__((address_space(4))) cfptr* ka = (const __attribute__((address_space(4))) cfptr*)__builtin_amdgcn_kernarg_segment_ptr(); return ka[i]; }
__device__ __forceinline__ int obid() { int b = blockIdx.x; asm volatile("" : "+s"(b)); return b; }
__device__ __forceinline__ int modrow_of(int seg, int row) { const int tok = seg * 8192 + row; return tok < 8192 ? 0 : 1 + ((tok - 8192) >> 12); }

namespace pg8 {
constexpr int BM = 256, BK = 64, HALF = 128, HTB = HALF * BK * 2, STAGE_BYTES = 8 * HTB, NXCD = 8, WGM = 8;
__host__ __device__ __forceinline__ int lds_byte(int r, int c) { const int st = (r >> 4) * 2 + (c >> 5), rr = r & 15, cc = c & 31, ob = rr * 64 + cc * 2; return st * 1024 + (ob ^ (((ob >> 9) & 1) << 5)); }
__host__ __device__ __forceinline__ void stage_rc(int b, int& R, int& C) { const int st = b / 1024, sb = b % 1024, swz = sb ^ (((sb >> 9) & 1) << 5); R = (st >> 1) * 16 + swz / 64; C = (st & 1) * 32 + (swz % 64) / 2; }
__host__ __device__ __forceinline__ int perm32(int rho) { const int n = rho >> 4, i = rho & 15; return 8 * (i >> 2) + 4 * n + (i & 3); }
struct Unit { int pm, pn; };
struct Gemm { const bf16_t* A; const bf16_t* Bt; int M, N, K, lda, ldb, ak_mod, ak_bytes; };
struct StaticOrder {
    int nM, nN, nwg, G, c;
    __device__ void init(int M, int N, int G_, int c_) { nM = M / BM; nN = N / BM; nwg = nM * nN; G = G_; c = c_; }
    __device__ bool next(int i, Unit& u) const {
        const long L = (long)i * G + c; if (L >= nwg) return false;
        int wgid = (int)L; { const int q = nwg / NXCD, r = nwg % NXCD, xcd = wgid % NXCD, off = wgid / NXCD; wgid = (xcd < r ? xcd * (q + 1) : r * (q + 1) + (xcd - r) * q) + off; }
        const int nig = WGM * nN, gid = wgid / nig, fm = gid * WGM, gsz = (nM - fm) < WGM ? (nM - fm) : WGM;
        u.pm = fm + ((wgid % nig) % gsz); u.pn = (wgid % nig) / gsz; return true;
    }
};
template <class Epi>
__device__ __forceinline__ void gemm_phase(LAS unsigned char* lds, const Gemm g, const StaticOrder& S, const Epi& E) {
    const int tid = otid(), wid = __builtin_amdgcn_readfirstlane(tid >> 6), lane = tid & 63, wr = wid >> 2, wc = wid & 3, fr = lane & 15, fq = lane >> 4;
    int K = g.K; asm volatile("" : "+s"(K)); const int nt = K / BK;
    unsigned voffA[2], voffB[2];
#pragma unroll
    for (int i = 0; i < 2; ++i) { int R, C; stage_rc(tid * 16 + i * 8192, R, C); const int Rb = Epi::PERM ? ((R & ~31) + perm32(R & 31)) : R;
        voffA[i] = (unsigned)(R * g.lda + C) * 2u; voffB[i] = (unsigned)(Rb * g.ldb + C) * 2u; }
    const size_t kstep = (size_t)(BK * 2);
    const size_t hA = (size_t)HALF * g.lda * 2, hB = (size_t)HALF * g.ldb * 2;
    const size_t tA = 2 * hA, tB = 2 * hB;
    const unsigned ldsw = (unsigned)wid * 1024u;
    const int aoff = lds_byte(wr * 64 + fr, fq * 8), boff = lds_byte(wc * 32 + fr, fq * 8);
#define PG8_SA(b, h) (((b) * 2 + (h)) * HTB)
#define PG8_SB(b, h) ((4 + (b) * 2 + (h)) * HTB)
#define PG8_STAGE(bufoff, gbase, voff) do { _Pragma("unroll") for (int _i = 0; _i < 2; ++_i) \
        __builtin_amdgcn_global_load_lds((const unsigned*)((const char*)(gbase) + (voff)[_i]), (LAS unsigned*)(lds + (bufoff) + ldsw + _i * 8192), 16, 0, 0); } while (0)
#define PG8_LDA(dst, b, h) do { _Pragma("unroll") for (int m = 0; m < 4; ++m) _Pragma("unroll") for (int k = 0; k < 2; ++k) dst[m][k] = *(const LAS bf16x8*)(lds + PG8_SA(b, h) + aoff + m * 2048 + k * 1024); } while (0)
#define PG8_LDB(dst, b, h) do { _Pragma("unroll") for (int n = 0; n < 2; ++n) _Pragma("unroll") for (int k = 0; k < 2; ++k) dst[n][k] = *(const LAS bf16x8*)(lds + PG8_SB(b, h) + boff + n * 2048 + k * 1024); } while (0)
#define PG8_MMA(ai, bj, At, Bt) do { __builtin_amdgcn_s_setprio(1); _Pragma("unroll") for (int m = 0; m < 4; ++m) _Pragma("unroll") for (int n = 0; n < 2; ++n) _Pragma("unroll") for (int k = 0; k < 2; ++k) \
        acc[ai][bj][m][n] = __builtin_amdgcn_mfma_f32_16x16x32_bf16(Bt[n][k], At[m][k], acc[ai][bj][m][n], 0, 0, 0); __builtin_amdgcn_s_setprio(0); } while (0)
#define PG8_WAIT_V(n) asm volatile("s_waitcnt vmcnt(" #n ")" ::: "memory")
#define PG8_WAIT_L(n) asm volatile("s_waitcnt lgkmcnt(" #n ")" ::: "memory")
#define PG8_BAR __builtin_amdgcn_s_barrier()
#define PG8_SCHED __builtin_amdgcn_sched_barrier(0)
#define PG8_UA(u) ((const char*)g.A + (size_t)(u).pm * tA + (size_t)(((u).pn % g.ak_mod) >> 1) * (size_t)g.ak_bytes)
    Unit cur, nxt; int ui = 0;
    if (!S.next(0, cur)) return;
    f32x4 acc[2][2][4][2];
#pragma unroll
    for (int a = 0; a < 2; ++a)
#pragma unroll
        for (int b = 0; b < 2; ++b)
#pragma unroll
            for (int m = 0; m < 4; ++m)
#pragma unroll
                for (int n = 0; n < 2; ++n) acc[a][b][m][n] = (f32x4){0.f, 0.f, 0.f, 0.f};
    bf16x8 At[4][2], B0[2][2], B1[2][2];
    const char* cA = PG8_UA(cur); const char* cB = (const char*)g.Bt + (size_t)cur.pn * tB;
    PG8_STAGE(PG8_SB(0, 0), cB, voffB); PG8_STAGE(PG8_SA(0, 0), cA, voffA); PG8_STAGE(PG8_SB(0, 1), cB + hB, voffB); PG8_STAGE(PG8_SA(0, 1), cA + hA, voffA);
    if (wr == 1) PG8_BAR;
    PG8_WAIT_V(4); PG8_BAR;
    PG8_STAGE(PG8_SB(1, 0), cB + kstep, voffB); PG8_STAGE(PG8_SA(1, 0), cA + kstep, voffA); PG8_STAGE(PG8_SB(1, 1), cB + hB + kstep, voffB);
    PG8_WAIT_V(6); PG8_BAR;
    for (;;) {
        const bool has_next = S.next(ui + 1, nxt);
        const char* nA = has_next ? PG8_UA(nxt) : cA; const char* nB = has_next ? (const char*)g.Bt + (size_t)nxt.pn * tB : cB;
        for (int t = 0; t < nt; t += 2) {
            const bool last = (t == nt - 2);
            const char* a1 = cA + (size_t)(t + 1) * kstep;
            const char* a2 = last ? nA : cA + (size_t)(t + 2) * kstep; const char* b2 = last ? nB : cB + (size_t)(t + 2) * kstep;
            const char* a3 = a2 + kstep; const char* b3 = b2 + kstep;
            PG8_LDB(B0, 0, 0); PG8_SCHED; PG8_LDA(At, 0, 0); PG8_STAGE(PG8_SA(1, 1), a1 + hA, voffA);
            PG8_WAIT_L(8); PG8_BAR; PG8_WAIT_L(0); PG8_MMA(0, 0, At, B0); PG8_BAR; PG8_SCHED;
            PG8_LDB(B1, 0, 1); PG8_STAGE(PG8_SB(0, 0), b2, voffB);
            PG8_BAR; PG8_WAIT_L(0); PG8_MMA(0, 1, At, B1); PG8_BAR;
            PG8_LDA(At, 0, 1); PG8_STAGE(PG8_SA(0, 0), a2, voffA);
            PG8_BAR; PG8_WAIT_L(0); PG8_MMA(1, 0, At, B0); PG8_BAR; PG8_SCHED;
            PG8_STAGE(PG8_SB(0, 1), b2 + hB, voffB);
            PG8_WAIT_V(6); PG8_BAR; PG8_MMA(1, 1, At, B1); PG8_BAR;
            PG8_LDB(B0, 1, 0); PG8_SCHED; PG8_LDA(At, 1, 0); PG8_STAGE(PG8_SA(0, 1), a2 + hA, voffA);
            PG8_WAIT_L(8); PG8_BAR; PG8_WAIT_L(0); PG8_MMA(0, 0, At, B0); PG8_BAR; PG8_SCHED;
            PG8_LDB(B1, 1, 1); PG8_STAGE(PG8_SB(1, 0), b3, voffB);
            PG8_BAR; PG8_WAIT_L(0); PG8_MMA(0, 1, At, B1); PG8_BAR;
            PG8_LDA(At, 1, 1); PG8_STAGE(PG8_SA(1, 0), a3, voffA);
            PG8_BAR; PG8_WAIT_L(0); PG8_MMA(1, 0, At, B0); PG8_BAR; PG8_SCHED;
            PG8_STAGE(PG8_SB(1, 1), b3 + hB, voffB);
            PG8_WAIT_V(6); PG8_BAR; PG8_MMA(1, 1, At, B1); PG8_BAR;
        }
        { int efr = fr, efq = fq; asm volatile("" : "+v"(efr), "+v"(efq)); E(acc, cur, wr, wc, efr, efq); }
        if (!has_next) break;
#pragma unroll
        for (int a = 0; a < 2; ++a)
#pragma unroll
            for (int b = 0; b < 2; ++b)
#pragma unroll
                for (int m = 0; m < 4; ++m)
#pragma unroll
                    for (int n = 0; n < 2; ++n) acc[a][b][m][n] = (f32x4){0.f, 0.f, 0.f, 0.f};
        cur = nxt; cA = nA; cB = nB; ++ui;
    }
    PG8_WAIT_V(0);
    if (wr == 0) PG8_BAR;
    PG8_BAR;
#undef PG8_SA
#undef PG8_SB
#undef PG8_STAGE
#undef PG8_LDA
#undef PG8_LDB
#undef PG8_MMA
#undef PG8_WAIT_V
#undef PG8_WAIT_L
#undef PG8_BAR
#undef PG8_SCHED
#undef PG8_UA
}
}
using pg8::Unit;
typedef f32x4 AccT[2][2][4][2];

struct EpiProj {
    static constexpr bool PERM = true;
    bf16_t* O; int col_off;
    __device__ __forceinline__ void operator()(const AccT& acc, const Unit& u, int wr, int wc, int fr, int fq) const {
        const int colt = u.pn * 256 + col_off;
        int act = 0;
        if (colt < 512) act = 1;
        const int row0 = u.pm * 256 + wr * 64 + fr, col0 = colt + wc * 32 + 8 * fq;
#pragma unroll
        for (int ai = 0; ai < 2; ++ai)
#pragma unroll
            for (int m = 0; m < 4; ++m) { bf16_t* rowp = O + (size_t)(row0 + ai * 128 + m * 16) * LDP + col0;
#pragma unroll
                for (int bj = 0; bj < 2; ++bj) { float v[8];
#pragma unroll
                    for (int j = 0; j < 4; ++j) { v[j] = acc[ai][bj][m][0][j]; v[4 + j] = acc[ai][bj][m][1][j]; }
                    u32x4 w; w.x = pk2(v[0], v[1]); w.y = pk2(v[2], v[3]); w.z = pk2(v[4], v[5]); w.w = pk2(v[6], v[7]);
                    *(u32x4*)(rowp + bj * 128) = w; } }
    }
};
struct EpiLruGate {
    static constexpr bool PERM = false;
    const bf16_t* XC; unsigned* LAB; const float* cl; const float* ba; const float* bi;
    __device__ __forceinline__ void operator()(const AccT& acc, const Unit& u, int wr, int wc, int fr, int fq) const {
        const int e = u.pn / 12, nb = u.pn % 12;
        const int row0 = u.pm * 256 + wr * 64 + fr;
#pragma unroll
        for (int bj = 0; bj < 2; ++bj) {
            const int ch0 = nb * 128 + 16 * (4 * bj + wc) + 4 * fq;
            const f32x4 vcl = *(const f32x4*)(cl + e * 1536 + ch0), vba = *(const f32x4*)(ba + e * 1536 + ch0), vbi = *(const f32x4*)(bi + e * 1536 + ch0);
#pragma unroll
            for (int ai = 0; ai < 2; ++ai)
#pragma unroll
                for (int m = 0; m < 4; ++m) { const int row = row0 + ai * 128 + m * 16;
                    const u32x2 xw = *(const u32x2*)(XC + (size_t)row * 1536 + ch0);
                    const float xc[4] = {bflo(xw.x), bfhi(xw.x), bflo(xw.y), bfhi(xw.y)};
                    u32x4 w;
#pragma unroll
                    for (int j = 0; j < 4; ++j) { const float ga = acc[ai][bj][m][0][j] + vba[j], gi = acc[ai][bj][m][1][j] + vbi[j];
                        const float la = vcl[j] * sigm(ga);
                        const float bc = __builtin_amdgcn_sqrtf(fmaxf(-expm1_(2.f * la), 0.f)) * sigm(gi) * xc[j];
                        w[j] = pk2(la, bc); }
                    *(u32x4*)(LAB + ((size_t)row * 2 + e) * 1536 + ch0) = w; __builtin_amdgcn_sched_barrier(0); }
        }
    }
};
struct EpiGlu {
    static constexpr bool PERM = true;
    const bf16_t* YSA; bf16_t* YS5;
    __device__ __forceinline__ void operator()(const AccT& acc, const Unit& u, int wr, int wc, int fr, int fq) const {
        const int row0 = u.pm * 256 + wr * 64 + fr, col0 = u.pn * 256 + wc * 32 + 8 * fq;
#pragma unroll
        for (int ai = 0; ai < 2; ++ai)
#pragma unroll
            for (int m = 0; m < 4; ++m) { const size_t ro = (size_t)(row0 + ai * 128 + m * 16) * 1024 + col0;
#pragma unroll
                for (int bj = 0; bj < 2; ++bj) { const u32x4 a = *(const u32x4*)(YSA + ro + bj * 128);
                    const float y[8] = {bflo(a.x), bfhi(a.x), bflo(a.y), bfhi(a.y), bflo(a.z), bfhi(a.z), bflo(a.w), bfhi(a.w)};
                    float v[8];
#pragma unroll
                    for (int j = 0; j < 4; ++j) { v[j] = y[j] * sigm(acc[ai][bj][m][0][j]); v[4 + j] = y[4 + j] * sigm(acc[ai][bj][m][1][j]); }
                    u32x4 w; w.x = pk2(v[0], v[1]); w.y = pk2(v[2], v[3]); w.z = pk2(v[4], v[5]); w.w = pk2(v[6], v[7]);
                    *(u32x4*)(YS5 + ro + bj * 128) = w; } }
    }
};
struct EpiMerge {
    static constexpr bool PERM = true;
    int mode; const bf16_t* G; float* MRG; bf16_t* MERGED;
    __device__ __forceinline__ void operator()(const AccT& acc, const Unit& u, int wr, int wc, int fr, int fq) const {
        const int row0 = u.pm * 256 + wr * 64 + fr, col0 = u.pn * 256 + wc * 32 + 8 * fq;
#pragma unroll
        for (int ai = 0; ai < 2; ++ai)
#pragma unroll
            for (int m = 0; m < 4; ++m) { const int row = row0 + ai * 128 + m * 16;
#pragma unroll
                for (int bj = 0; bj < 2; ++bj) { const int col = col0 + bj * 128;
                    const u32x4 a = *(const u32x4*)(G + (size_t)row * LDP + col);
                    const float gg[8] = {sigm(bflo(a.x)), sigm(bfhi(a.x)), sigm(bflo(a.y)), sigm(bfhi(a.y)), sigm(bflo(a.z)), sigm(bfhi(a.z)), sigm(bflo(a.w)), sigm(bfhi(a.w))};
                    float* mp = MRG + (size_t)row * 1024 + col;
                    f32x4 v0, v1;
#pragma unroll
                    for (int j = 0; j < 4; ++j) { v0[j] = gg[j] * acc[ai][bj][m][0][j]; v1[j] = gg[4 + j] * acc[ai][bj][m][1][j]; }
                    if (mode != 0) { v0 += *(const f32x4*)mp; v1 += *(const f32x4*)(mp + 4); }
                    if (mode != 2) { *(f32x4*)mp = v0; *(f32x4*)(mp + 4) = v1; }
                    else { u32x4 w; w.x = pk2(v0[0], v0[1]); w.y = pk2(v0[2], v0[3]); w.z = pk2(v1[0], v1[1]); w.w = pk2(v1[2], v1[3]);
                        *(u32x4*)(MERGED + (size_t)row * 1024 + col) = w; } } }
    }
};
struct EpiRes {
    static constexpr bool PERM = false;
    const float* X; const float* gate; int seg; float* PRE; float xs;
    __device__ __forceinline__ void operator()(const AccT& acc, const Unit& u, int wr, int wc, int fr, int fq) const {
        const int row0 = u.pm * 256 + wr * 64 + fr, col0 = u.pn * 256 + wc * 32 + 4 * fq;
#pragma unroll
        for (int ai = 0; ai < 2; ++ai)
#pragma unroll
            for (int m = 0; m < 4; ++m) { const int row = row0 + ai * 128 + m * 16; const float* gp = gate + (size_t)modrow_of(seg, row) * 6144;
#pragma unroll
                for (int bj = 0; bj < 2; ++bj)
#pragma unroll
                    for (int n = 0; n < 2; ++n) { const int col = col0 + bj * 128 + n * 16;
                        const f32x4 xv = *(const f32x4*)(X + (size_t)row * 1024 + col), gv = *(const f32x4*)(gp + col);
                        *(f32x4*)(PRE + (size_t)row * 1024 + col) = xs * xv + gv * acc[ai][bj][m][n]; } }
    }
};
struct EpiRelu2 {
    static constexpr bool PERM = true;
    bf16_t* O;
    __device__ __forceinline__ void operator()(const AccT& acc, const Unit& u, int wr, int wc, int fr, int fq) const {
        const int row0 = u.pm * 256 + wr * 64 + fr, col0 = u.pn * 256 + wc * 32 + 8 * fq;
#pragma unroll
        for (int ai = 0; ai < 2; ++ai)
#pragma unroll
            for (int m = 0; m < 4; ++m) { bf16_t* rowp = O + (size_t)(row0 + ai * 128 + m * 16) * 4096 + col0;
#pragma unroll
                for (int bj = 0; bj < 2; ++bj) { float v[8];
#pragma unroll
                    for (int j = 0; j < 4; ++j) { float a = fmaxf(acc[ai][bj][m][0][j], 0.f), b = fmaxf(acc[ai][bj][m][1][j], 0.f); v[j] = a * a; v[4 + j] = b * b; }
                    u32x4 w; w.x = pk2(v[0], v[1]); w.y = pk2(v[2], v[3]); w.z = pk2(v[4], v[5]); w.w = pk2(v[6], v[7]);
                    *(u32x4*)(rowp + bj * 128) = w; } }
    }
};

template <class Epi>
__device__ __forceinline__ void run_gemm(unsigned char* lds, const bf16_t* A, int lda, const bf16_t* Bt, int ldb, int M, int N, int K, int ak_mod, int ak_bytes, const Epi& E) {
    pg8::Gemm g; g.A = A; g.Bt = Bt; g.M = M; g.N = N; g.K = K; g.lda = lda; g.ldb = ldb; g.ak_mod = ak_mod; g.ak_bytes = ak_bytes;
    pg8::StaticOrder S; S.init(M, N, (int)gridDim.x, (int)obid());
    pg8::gemm_phase<Epi>((LAS unsigned char*)lds, g, S, E);
}

template <class Epi>
__device__ __forceinline__ void run_gemm_sub(unsigned char* lds, const bf16_t* A, int lda, const bf16_t* Bt, int ldb, int M, int N, int K, int G, int c, const Epi& E) {
    pg8::Gemm g; g.A = A; g.Bt = Bt; g.M = M; g.N = N; g.K = K; g.lda = lda; g.ldb = ldb; g.ak_mod = 1; g.ak_bytes = 0;
    pg8::StaticOrder S; S.init(M, N, G, c);
    pg8::gemm_phase<Epi>((LAS unsigned char*)lds, g, S, E);
}
__device__ __forceinline__ void phase_mods(const Params& p, unsigned char* lds) {
    const int z = ozero();
    const int tid = otid();
    float* SC = (float*)lds;
    float* PS = (float*)(lds + 36864);
    const float* c = kin(6 + z); const float* cctx = kin(7 + z);
    for (int i = tid; i < 9 * 1024; i += 512) { const int r = i >> 10, k = i & 1023; const float v = r == 0 ? cctx[k] : c[(r - 1) * 1024 + k]; SC[i] = v * sigm(v); }
    __syncthreads();
    float* MOD = (float*)(((unsigned char*)kin(41 + z)) + WS_MOD);
    for (int it = obid(); it < 4 * 48; it += gridDim.x) {
        const int l = it / 48, cb = it % 48; const int col = cb * 128 + (tid & 127), kq = tid >> 7;
        const float* W = kin(8 + z) + (size_t)l * 1024 * 6144 + col;
        float a[9];
#pragma unroll
        for (int r = 0; r < 9; ++r) a[r] = 0.f;
        for (int k = kq * 256; k < kq * 256 + 256; ++k) { const float w = W[(size_t)k * 6144];
#pragma unroll
            for (int r = 0; r < 9; ++r) a[r] += SC[r * 1024 + k] * w; }
#pragma unroll
        for (int r = 0; r < 9; ++r) PS[(kq * 9 + r) * 128 + (tid & 127)] = a[r];
        __syncthreads();
        if (tid < 128) { const float b = kin(9 + z)[l * 6144 + col];
#pragma unroll
            for (int r = 0; r < 9; ++r) MOD[((size_t)l * 9 + r) * 6144 + col] = PS[(0 * 9 + r) * 128 + tid] + PS[(1 * 9 + r) * 128 + tid] + PS[(2 * 9 + r) * 128 + tid] + PS[(3 * 9 + r) * 128 + tid] + b; }
        __syncthreads();
    }
}
__device__ __forceinline__ void phase_xinit(const Params& p) {
    const int z = ozero();
    const size_t n4 = (size_t)40960 * 256; const size_t gs = (size_t)gridDim.x * 512;
    for (size_t i = (size_t)obid() * 512 + otid(); i < n4; i += gs) {
        const int tok = (int)(i >> 8), d0 = (int)(i & 255) * 4;
        f32x4 v;
        if (tok < 8192) v = *(const f32x4*)(kin(0 + z) + (size_t)tok * 1024 + d0);
        else { const int tl = tok - 8192; v = *(const f32x4*)(kin(1 + z) + (size_t)tl * 1024 + d0); const int t = tl & 4095;
#pragma unroll
            for (int j = 0; j < 4; ++j) { const int d = d0 + j, qt = d >> 8, i2 = d & 255;
                const float om = exp2f(-(float)i2 * (13.287712379549449f / 256.f));
                const float ps = (qt < 2) ? (float)(t >> 6) : (float)(t & 63);
                const float ag = ps * om;
                v[j] += (qt & 1) ? __cosf(ag) : __sinf(ag); } }
        *(f32x4*)(((float*)kin(40 + z)) + (size_t)tok * 1024 + d0) = v;
        {
            const float* MOD = (const float*)(((unsigned char*)kin(41 + z)) + WS_MOD); bf16_t* HA = (bf16_t*)(((unsigned char*)kin(41 + z)) + WS_HA);
            const int mr = tok < 8192 ? 0 : 1 + ((tok - 8192) >> 12);
            const f32x4 sh = *(const f32x4*)(MOD + (size_t)mr * 6144 + d0), sc = *(const f32x4*)(MOD + (size_t)mr * 6144 + 1024 + d0);
            u32x2 w; w.x = pk2(v[0] * (1.f + sc[0]) + sh[0], v[1] * (1.f + sc[1]) + sh[1]); w.y = pk2(v[2] * (1.f + sc[2]) + sh[2], v[3] * (1.f + sc[3]) + sh[3]);
            *(u32x2*)(HA + (size_t)tok * 1024 + d0) = w; }
    }
}
__device__ __forceinline__ void phase_ha0(const Params& p) {
    const int z = ozero();
    const float* MOD = (const float*)(((unsigned char*)kin(41 + z)) + WS_MOD); bf16_t* HA = (bf16_t*)(((unsigned char*)kin(41 + z)) + WS_HA);
    const size_t n4 = (size_t)40960 * 256; const size_t gs = (size_t)gridDim.x * 512;
    for (size_t i = (size_t)obid() * 512 + otid(); i < n4; i += gs) {
        const int tok = (int)(i >> 8), d0 = (int)(i & 255) * 4;
        const int mr = tok < 8192 ? 0 : 1 + ((tok - 8192) >> 12);
        const f32x4 x = *(const f32x4*)(((float*)kin(40 + z)) + (size_t)tok * 1024 + d0);
        const f32x4 sh = *(const f32x4*)(MOD + (size_t)mr * 6144 + d0), sc = *(const f32x4*)(MOD + (size_t)mr * 6144 + 1024 + d0);
        u32x2 w; w.x = pk2(x[0] * (1.f + sc[0]) + sh[0], x[1] * (1.f + sc[1]) + sh[1]); w.y = pk2(x[2] * (1.f + sc[2]) + sh[2], x[3] * (1.f + sc[3]) + sh[3]);
        *(u32x2*)(HA + (size_t)tok * 1024 + d0) = w;
    }
}
struct TrT { const float* src; bf16_t* dst; int ldn, k0, n0, ldd, dr, kofs, mode; float scale; };
__device__ __forceinline__ TrT tr_decode(int it, int l, int z, unsigned char* ws) {
    TrT t; t.kofs = 0; t.mode = 0; t.scale = 1.f;
    int i = it;
    if (i < 2568) { const int kt = i & 7, nt = i >> 3; const int n0 = nt * 32;
        t.src = kin(10 + z) + (size_t)l * 1024 * 10272; t.ldn = 10272; t.k0 = kt * 128; t.n0 = n0; t.dst = (bf16_t*)(ws + WS_WIN); t.ldd = 1024;
        t.dr = n0 < 3072 ? n0 : (n0 < 3104 ? 10240 + (n0 - 3072) : n0 - 32); if (n0 < 512) t.scale = 0.08838834764831845f;
        return t; }
    i -= 2568;
    if (i < 256) { t.src = kin(22 + z) + (size_t)l * 1048576; t.ldn = 1024; t.k0 = (i & 7) * 128; t.n0 = (i >> 3) * 32; t.dst = (bf16_t*)(ws + WS_WGLU); t.ldd = 1024; t.dr = (i >> 3) * 32; return t; }
    i -= 256;
    if (i < 256) { t.src = kin(30 + z) + (size_t)l * 1048576; t.ldn = 1024; t.k0 = (i & 7) * 128; t.n0 = (i >> 3) * 32; t.dst = (bf16_t*)(ws + WS_WBG); t.ldd = 1024; t.dr = (i >> 3) * 32; return t; }
    i -= 256;
    if (i < 256) { t.src = kin(31 + z) + (size_t)l * 1048576; t.ldn = 1024; t.k0 = (i & 7) * 128; t.n0 = (i >> 3) * 32; t.dst = (bf16_t*)(ws + WS_WBS); t.ldd = 1024; t.dr = (i >> 3) * 32; return t; }
    i -= 256;
    if (i < 384) { const int kt = i % 12, nt = i / 12; t.src = kin(32 + z) + (size_t)l * 1536 * 1024; t.ldn = 1024; t.k0 = kt * 128; t.n0 = nt * 32; t.dst = (bf16_t*)(ws + WS_WBL); t.ldd = 1536; t.dr = nt * 32; return t; }
    i -= 384;
    if (i < 256) { t.src = kin(33 + z) + (size_t)l * 1048576; t.ldn = 1024; t.k0 = (i & 7) * 128; t.n0 = (i >> 3) * 32; t.dst = (bf16_t*)(ws + WS_WOUT); t.ldd = 1024; t.dr = (i >> 3) * 32; return t; }
    i -= 256;
    if (i < 1024) { t.src = kin(38 + z) + (size_t)l * 4194304; t.ldn = 4096; t.k0 = (i & 7) * 128; t.n0 = (i >> 3) * 32; t.dst = (bf16_t*)(ws + WS_WMI); t.ldd = 1024; t.dr = (i >> 3) * 32; return t; }
    i -= 1024;
    if (i < 1024) { t.src = kin(39 + z) + (size_t)l * 4194304; t.ldn = 1024; t.k0 = (i & 31) * 128; t.n0 = (i >> 5) * 32; t.dst = (bf16_t*)(ws + WS_WMO); t.ldd = 4096; t.dr = (i >> 5) * 32; return t; }
    i -= 1024;
    { const int dt = i & 3; int r = i >> 2; const int nb = r % 12; r /= 12; const int e = r & 1, ai = r >> 1;
        t.src = (ai ? kin(27 + z) : kin(25 + z)) + ((size_t)(l * 2 + e) * 12 + nb) * 16384; t.ldn = 128; t.k0 = 0; t.n0 = dt * 32; t.dst = (bf16_t*)(ws + WS_WLRU); t.ldd = 256;
        t.dr = (e * 12 + nb) * 256 + (dt * 2) * 32 + ai * 16; t.kofs = (nb & 1) * 128; t.mode = 1; }
    return t;
}
__device__ __forceinline__ void tr_load(const TrT& t, float (&v)[8], int tid) {
#pragma unroll
    for (int i = 0; i < 8; ++i) { const int kk = (tid >> 5) + 16 * i, nn = tid & 31; v[i] = __builtin_nontemporal_load(t.src + (size_t)(t.k0 + kk) * t.ldn + t.n0 + nn); }
}
__device__ __forceinline__ void tr_store(unsigned char* lds, const TrT& t, const float (&v)[8], int tid) {
    float* tile = (float*)lds;
#pragma unroll
    for (int i = 0; i < 8; ++i) { const int kk = (tid >> 5) + 16 * i, nn = tid & 31; tile[kk * 33 + nn] = v[i]; }
    __syncthreads();
    const int nn = tid >> 4, kq = tid & 15;
    u32x4 w;
#pragma unroll
    for (int j = 0; j < 4; ++j) w[j] = pk2(tile[(kq * 8 + 2 * j) * 33 + nn] * t.scale, tile[(kq * 8 + 2 * j + 1) * 33 + nn] * t.scale);
    const int row = t.mode ? t.dr + (nn >> 4) * 32 + (nn & 15) : t.dr + nn;
    *(u32x4*)(t.dst + (size_t)row * t.ldd + t.kofs + t.k0 + kq * 8) = w;
    if (t.mode) *(u32x4*)(t.dst + (size_t)row * t.ldd + (128 - t.kofs) + kq * 8) = (u32x4){0u, 0u, 0u, 0u};
    __syncthreads();
}
__device__ __forceinline__ void phase_layer_setup(const Params& p, int l, unsigned char* lds) {
    const int z = ozero();
    unsigned char* ws = (unsigned char*)kin(41 + z);
    { const int tid = otid(), G = (int)gridDim.x; int it = obid();
        if (it < 6216) { TrT cur = tr_decode(it, l, z, ws); float v[8]; tr_load(cur, v, tid);
            for (;;) { const int nx = it + G; const bool hn = nx < 6216; TrT nxt = cur; float w[8];
                if (hn) { nxt = tr_decode(nx, l, z, ws); tr_load(nxt, w, tid); }
                tr_store(lds, cur, v, tid);
                if (!hn) break;
                cur = nxt; it = nx;
#pragma unroll
                for (int q = 0; q < 8; ++q) v[q] = w[q]; } } }
    const int gt = obid() * 512 + otid(), gs = gridDim.x * 512;
    for (int i = gt; i < 224 * 128; i += gs) *(u32x4*)((bf16_t*)(ws + WS_WIN) + (size_t)10272 * 1024 + (size_t)i * 8) = (u32x4){0u, 0u, 0u, 0u};
    for (int i = gt; i < 2 * 64 * 64; i += gs) { const int pp = i & 63, G = (i >> 6) & 63, e = i >> 12;
        const float step = __expf(kin(16 + z)[(l * 2 + e) * 64 + G]);
        const float lr = kin(14 + z)[((size_t)(l * 2 + e) * 64 + G) * 64 + pp], li = kin(15 + z)[((size_t)(l * 2 + e) * 64 + G) * 64 + pp];
        const float mag = __expf(lr * step), ang = li * step;
        const float are = mag * __cosf(ang), aim = mag * __sinf(ang);
        const float den = lr * lr + li * li, nr = are - 1.f;
        const float fre = (nr * lr + aim * li) / den, fim = (aim * lr - nr * li) / den;
        ((float2*)(ws + WS_S5AB))[i] = make_float2(are, aim);
        const float* bre = kin(17 + z) + ((size_t)(l * 64 + G) * 64 + pp) * 16; const float* bim = kin(18 + z) + ((size_t)(l * 64 + G) * 64 + pp) * 16;
        bf16_t* o = (bf16_t*)(ws + WS_S5B) + ((size_t)(e * 64 + G) * 128) * 16;
#pragma unroll
        for (int j = 0; j < 16; ++j) { const float br = bre[j], bi = bim[j]; o[pp * 16 + j] = f2bf(fre * br - fim * bi); o[(64 + pp) * 16 + j] = f2bf(fre * bi + fim * br); } }
    for (int i = gt; i < 64 * 16 * 64; i += gs) { const int pp = i & 63, ii = (i >> 6) & 15, G = i >> 10;
        bf16_t* o = (bf16_t*)(ws + WS_S5C) + ((size_t)G * 16 + ii) * 128;
        o[pp] = f2bf(kin(19 + z)[((size_t)(l * 64 + G) * 16 + ii) * 64 + pp]); o[64 + pp] = f2bf(-kin(20 + z)[((size_t)(l * 64 + G) * 16 + ii) * 64 + pp]); }
    for (int i = gt; i < 2 * 1536; i += gs) { const float lam = kin(29 + z)[(size_t)l * 3072 + i]; ((float*)(ws + WS_LCL))[i] = -8.f * (fmaxf(-lam, 0.f) + log1p_(__expf(-fabsf(lam)))); }
}

__device__ __forceinline__ void phase_conv(const Params& p, int l, int seg) {
    const int z = ozero();
    const bf16_t* PROJ = (const bf16_t*)(((unsigned char*)kin(41 + z)) + WS_PROJ); bf16_t* XC = (bf16_t*)(((unsigned char*)kin(41 + z)) + WS_XC);
    const int T = seg == 0 ? 256 : 4096;
    const float* cw = kin(23 + z) + (size_t)l * 4 * 1536; const float* cb = kin(24 + z) + (size_t)l * 1536;
    const int bid = obid(); int nb = (int)gridDim.x, eb = bid;
    if (seg != 0) { if ((bid & 7) == 7) return; nb -= nb >> 3; eb = bid - (bid >> 3); }
    const int n = SEG * 192, gs = nb * 512;
    for (int i = eb * 512 + otid(); i < n; i += gs) {
        const int row = i / 192, ch = (i % 192) * 8; const int t = row & (T - 1);
        float a[8];
#pragma unroll
        for (int j = 0; j < 8; ++j) a[j] = cb[ch + j];
#pragma unroll
        for (int tap = 0; tap < 4; ++tap) { const int tt = t + tap - 2;
            if (tt >= 0 && tt < T) { const u32x4 v = *(const u32x4*)(PROJ + (size_t)(row + tap - 2) * LDP + CLX + ch);
                const float x[8] = {bflo(v.x), bfhi(v.x), bflo(v.y), bfhi(v.y), bflo(v.z), bfhi(v.z), bflo(v.w), bfhi(v.w)};
#pragma unroll
                for (int j = 0; j < 8; ++j) a[j] += cw[tap * 1536 + ch + j] * x[j]; } }
        u32x4 w; w.x = pk2(a[0], a[1]); w.y = pk2(a[2], a[3]); w.z = pk2(a[4], a[5]); w.w = pk2(a[6], a[7]);
        *(u32x4*)(XC + (size_t)row * 1536 + ch) = w;
    }
}

__device__ __forceinline__ void unpack8(const u32x4 a, float* y) { y[0] = bflo(a.x); y[1] = bfhi(a.x); y[2] = bflo(a.y); y[3] = bfhi(a.y); y[4] = bflo(a.z); y[5] = bfhi(a.z); y[6] = bflo(a.w); y[7] = bfhi(a.w); }
__device__ __forceinline__ u32x4 pack8(const float* v) { u32x4 w; w.x = pk2(v[0], v[1]); w.y = pk2(v[2], v[3]); w.z = pk2(v[4], v[5]); w.w = pk2(v[6], v[7]); return w; }
#define MFMA16(a, b, c) __builtin_amdgcn_mfma_f32_16x16x32_bf16(a, b, c, 0, 0, 0)

__device__ __forceinline__ void gla_items(const Params& p, int l, int seg, int pass, unsigned char* lds) {
    const int z = ozero();
    const int tid = otid(), lane = tid & 63, w = tid >> 6, quad = lane >> 4, l15 = lane & 15;
    const bool ctx = (seg == 0);
    const int T = ctx ? 256 : 4096, nseq = ctx ? 32 : 2, nsc = ctx ? 1 : 8, nch = ctx ? 4 : 8;
    if (pass == 1 && nsc == 1) return;
    const int nitems = nseq * 16 * nsc;
    unsigned char* ws = (unsigned char*)kin(41 + z);
    bf16_t* QD = (bf16_t*)(lds); bf16_t* KI = (bf16_t*)(lds + 17408); bf16_t* KET = (bf16_t*)(lds + 34816); bf16_t* VT = (bf16_t*)(lds + 53248);
    bf16_t* ST = (bf16_t*)(lds + 71680); float* CUM = (float*)(lds + 71680); bf16_t* Pm = (bf16_t*)(lds + 106496);
    bf16_t* GLRb = (bf16_t*)(lds + 115712);   float* DL = (float*)(lds + 121856); float* LAST = (float*)(lds + 122368);
    const bf16_t* PROJ = (const bf16_t*)(ws + WS_PROJ);
    float* GST = (float*)(ws + WS_GST); float* GLT = (float*)(ws + WS_GLT);
    const int k = tid & 127, part = tid >> 7;
    for (int it = obid(); it < nitems; it += gridDim.x) {
        const int sc = it % nsc; int r = it / nsc; const int vh = r & 1, dir = (r >> 1) & 1, h = (r >> 2) & 3, sq = r >> 4;
        if (pass == 1 && sc == nsc - 1) continue;
        bf16x8 wgb = (bf16x8){0, 0, 0, 0, 0, 0, 0, 0};
        if (quad < 2) { float wv8[8];
#pragma unroll
            for (int j = 0; j < 8; ++j) wv8[j] = kin(11 + z)[((size_t)(l * 2 + dir) * 16 + quad * 8 + j) * 512 + h * 128 + w * 16 + l15];
            const u32x4 pw = pack8(wv8); wgb = __builtin_bit_cast(bf16x8, pw); }
        const float bgk = kin(12 + z)[(size_t)(l * 2 + dir) * 512 + h * 128 + w * 16 + l15];
        f32x4 accs[8];
        float ltot = 0.f;
        if (pass == 2 && !ctx) {
            const int b = (seg - 1) * 2 + sq;
            const float* s0 = kin(2 + z) + ((((size_t)b * 4 + l) * 2 + dir) * 4 + h) * 32768 + vh * 128;
#pragma unroll
            for (int vt = 0; vt < 8; ++vt)
#pragma unroll
                for (int j = 0; j < 4; ++j) accs[vt][j] = s0[(size_t)(w * 16 + quad * 4 + j) * 256 + vt * 16 + l15];
            for (int j2 = 0; j2 < sc; ++j2) { const int itj = it - sc + j2; const float* sl = GST + (size_t)itj * 16384; const float* lt = GLT + (size_t)itj * 128;
                const f32x4 l4 = *(const f32x4*)(lt + w * 16 + quad * 4);
                const f32x4 dk = (f32x4){__expf(l4[0]), __expf(l4[1]), __expf(l4[2]), __expf(l4[3])};
#pragma unroll
                for (int vt = 0; vt < 8; ++vt) accs[vt] = dk * accs[vt] + *(const f32x4*)(sl + (vt * 16 + l15) * 128 + w * 16 + quad * 4); }
        } else {
#pragma unroll
            for (int vt = 0; vt < 8; ++vt) accs[vt] = (f32x4){0.f, 0.f, 0.f, 0.f};
        }
        bf16_t* Og = (bf16_t*)(ws + (dir ? WS_OB : WS_OF));
        const int rsgn = dir ? -1 : 1;
        const int rb0 = sq * T + (dir ? (T - 1 - sc * nch * 64) : sc * nch * 64);
#pragma unroll
        for (int i = 0; i < 2; ++i) { const int idx = tid + 512 * i; GLRb[(idx >> 4) * 24 + (idx & 15)] = PROJ[(size_t)(rb0 + rsgn * (idx >> 4)) * LDP + CGLR + dir * 16 + (idx & 15)]; }
        __syncthreads();
        for (int c = 0; c < nch; ++c) {
            const int rbase = rb0 + rsgn * c * 64;
            u32x4 q8r[2], k8r[2]; bf16_t kraw[2][8], vraw[2][8];
            if (pass == 2) {
#pragma unroll
                for (int i = 0; i < 2; ++i) { const int e = tid + 512 * i; const int tau = e >> 4, ko = (e & 15) * 8;
                    const bf16_t* rp = PROJ + (size_t)(rbase + rsgn * tau) * LDP + h * 128 + ko;
                    q8r[i] = *(const u32x4*)(rp + CQ); k8r[i] = *(const u32x4*)(rp + CK); }
            }
#pragma unroll
            for (int i = 0; i < 2; ++i) { const int e = tid + 512 * i; const int kk = e & 127, t0 = (e >> 7) * 8;
                const bf16_t* rp = PROJ + (size_t)(rbase + rsgn * t0) * LDP + h * 128 + kk;
#pragma unroll
                for (int j = 0; j < 8; ++j) { const bf16_t* rj = rp + (long)(rsgn * j) * LDP; kraw[i][j] = rj[CK]; vraw[i][j] = rj[CV + h * 128 + vh * 128]; } }
            { float base = 0.f;
#pragma unroll
                for (int tt = 0; tt < 4; ++tt) {
                    const bf16x8 a = quad < 2 ? *(const bf16x8*)&GLRb[(tt * 16 + l15) * 24 + quad * 8] : (bf16x8){0, 0, 0, 0, 0, 0, 0, 0};
                    const f32x4 lg4 = MFMA16(a, wgb, ((f32x4){0.f, 0.f, 0.f, 0.f}));
                    float c[4]; float run = 0.f;
#pragma unroll
                    for (int j = 0; j < 4; ++j) { run += logsig_(lg4[j] + bgk) * 0.0625f; c[j] = run; }
                    float v = run;
                    { const float t1 = __shfl_up(v, 16); if (quad >= 1) v += t1; const float t2 = __shfl_up(v, 32); if (quad >= 2) v += t2; }
                    const float tile_tot = __shfl(v, 48 + l15);
                    const float off = base + (v - run);
#pragma unroll
                    for (int j = 0; j < 4; ++j) CUM[(tt * 16 + quad * 4 + j) * 128 + w * 16 + l15] = c[j] + off;
                    base += tile_tot; }
                if (quad == 0) { LAST[w * 16 + l15] = base; DL[w * 16 + l15] = __expf(base); ltot += base; } }
            __syncthreads();
            if (pass == 2) {
#pragma unroll
                for (int i = 0; i < 2; ++i) { const int e = tid + 512 * i; const int tau = e >> 4, ko = (e & 15) * 8;
                    const u32x4 q8 = q8r[i], k8 = k8r[i];
                    const f32x4 c0 = *(const f32x4*)&CUM[tau * 128 + ko], c1 = *(const f32x4*)&CUM[tau * 128 + ko + 4];
                    float fq[8], fk[8], vq[8], vk[8]; unpack8(q8, fq); unpack8(k8, fk);
#pragma unroll
                    for (int j = 0; j < 8; ++j) { const float ec = __expf(j < 4 ? c0[j] : c1[j - 4]); vq[j] = fq[j] * ec; vk[j] = fk[j] * __builtin_amdgcn_rcpf(ec); }
                    *(u32x4*)&QD[tau * 136 + ko] = pack8(vq); *(u32x4*)&KI[tau * 136 + ko] = pack8(vk); }
            }
#pragma unroll
            for (int i = 0; i < 2; ++i) { const int e = tid + 512 * i; const int kk = e & 127, t0 = (e >> 7) * 8;
                const float lastv = LAST[kk];
                float vk[8]; bf16_t vv[8];
#pragma unroll
                for (int j = 0; j < 8; ++j) { vk[j] = bf2f(kraw[i][j]) * __expf(lastv - CUM[(t0 + j) * 128 + kk]); vv[j] = vraw[i][j]; }
                *(u32x4*)&KET[kk * 72 + t0] = pack8(vk);
                u32x4 wv; wv.x = (unsigned)vv[0] | ((unsigned)vv[1] << 16); wv.y = (unsigned)vv[2] | ((unsigned)vv[3] << 16); wv.z = (unsigned)vv[4] | ((unsigned)vv[5] << 16); wv.w = (unsigned)vv[6] | ((unsigned)vv[7] << 16);
                *(u32x4*)&VT[kk * 72 + t0] = wv; }
            if (c + 1 < nch) {
#pragma unroll
                for (int i = 0; i < 2; ++i) { const int idx = tid + 512 * i; GLRb[(idx >> 4) * 24 + (idx & 15)] = PROJ[(size_t)(rbase + rsgn * (64 + (idx >> 4))) * LDP + CGLR + dir * 16 + (idx & 15)]; } }
            __syncthreads();
            if (pass == 2) {
                { const int tt = w >> 1, st0 = (w & 1) * 2;
#pragma unroll
                    for (int s2 = 0; s2 < 2; ++s2) { const int st = st0 + s2; f32x4 a4 = (f32x4){0.f, 0.f, 0.f, 0.f};
#pragma unroll
                        for (int ks = 0; ks < 4; ++ks) { const bf16x8 a = *(const bf16x8*)&QD[(tt * 16 + l15) * 136 + ks * 32 + quad * 8]; const bf16x8 b = *(const bf16x8*)&KI[(st * 16 + l15) * 136 + ks * 32 + quad * 8]; a4 = MFMA16(a, b, a4); }
#pragma unroll
                        for (int j = 0; j < 4; ++j) { const int t = tt * 16 + quad * 4 + j, s = st * 16 + l15; Pm[t * 72 + s] = f2bf(s <= t ? a4[j] : 0.f); } } }
#pragma unroll
                for (int vt = 0; vt < 8; ++vt) { u32x2 sv; sv.x = pk2(accs[vt][0], accs[vt][1]); sv.y = pk2(accs[vt][2], accs[vt][3]); *(u32x2*)&ST[(vt * 16 + l15) * 136 + w * 16 + quad * 4] = sv; }
                __syncthreads();
#pragma unroll
                for (int tt = 0; tt < 4; ++tt) { f32x4 o = (f32x4){0.f, 0.f, 0.f, 0.f};
#pragma unroll
                    for (int ks = 0; ks < 2; ++ks) { const bf16x8 a = *(const bf16x8*)&Pm[(tt * 16 + l15) * 72 + ks * 32 + quad * 8]; const bf16x8 b = *(const bf16x8*)&VT[(w * 16 + l15) * 72 + ks * 32 + quad * 8]; o = MFMA16(a, b, o); }
#pragma unroll
                    for (int ks = 0; ks < 4; ++ks) { const bf16x8 a = *(const bf16x8*)&QD[(tt * 16 + l15) * 136 + ks * 32 + quad * 8]; const bf16x8 b = *(const bf16x8*)&ST[(w * 16 + l15) * 136 + ks * 32 + quad * 8]; o = MFMA16(a, b, o); }
#pragma unroll
                    for (int j = 0; j < 4; ++j) { const int tau = tt * 16 + quad * 4 + j; Og[(size_t)(rbase + rsgn * tau) * 1024 + h * 256 + vh * 128 + w * 16 + l15] = f2bf(o[j]); } }
            }
            { const f32x4 dl4 = *(const f32x4*)&DL[w * 16 + quad * 4];
                bf16x8 ak[2];
#pragma unroll
                for (int ks = 0; ks < 2; ++ks) ak[ks] = *(const bf16x8*)&KET[(w * 16 + l15) * 72 + ks * 32 + quad * 8];
#pragma unroll
                for (int vt = 0; vt < 8; ++vt) { accs[vt] *= dl4;
#pragma unroll
                    for (int ks = 0; ks < 2; ++ks) { const bf16x8 b = *(const bf16x8*)&VT[(vt * 16 + l15) * 72 + ks * 32 + quad * 8]; accs[vt] = MFMA16(ak[ks], b, accs[vt]); } } }
            __syncthreads();
        }
        if (pass == 1) {
            float* sl = GST + (size_t)it * 16384;
#pragma unroll
            for (int vt = 0; vt < 8; ++vt) *(f32x4*)(sl + (vt * 16 + l15) * 128 + w * 16 + quad * 4) = accs[vt];
            if (quad == 0) GLT[(size_t)it * 128 + w * 16 + l15] = ltot;
        } else if (ctx) {
            float* so = ((float*)kin(40 + z)) + OUT_GLA + ((((size_t)sq * 4 + l) * 2 + dir) * 4 + h) * 32768 + vh * 128;
#pragma unroll
            for (int vt = 0; vt < 8; ++vt)
#pragma unroll
                for (int j = 0; j < 4; ++j) so[(size_t)(w * 16 + quad * 4 + j) * 256 + vt * 16 + l15] = accs[vt][j];
        }
    }
}

#define WSYNC() asm volatile("s_waitcnt lgkmcnt(0)" ::: "memory")
__device__ __forceinline__ void s5_items(const Params& p, int l, int seg, int pass, unsigned char* lds) {
    const int z = ozero();
    const int tid = otid(), lane = tid & 63, w = tid >> 6, quad = lane >> 4, l15 = lane & 15;
    const bool ctx = (seg == 0);
    const int T = ctx ? 256 : 4096, nseq = ctx ? 32 : 2, nsc = ctx ? 1 : 8;
    if (pass == 1 && nsc == 1) return;
    const int Lsc = T / nsc, nsub = Lsc / 16;
    const int nitems = nseq * 16 * nsc;
    unsigned char* wl = lds + w * 13824;
    bf16_t* UL = (bf16_t*)wl;
    float* X = (float*)(wl + 768);
    bf16_t* H = (bf16_t*)(wl + 768 + 8448);
    const bf16_t* PROJ = (const bf16_t*)(((unsigned char*)kin(41 + z)) + WS_PROJ);
    const float2* AB = (const float2*)(((unsigned char*)kin(41 + z)) + WS_S5AB); const bf16_t* SB = (const bf16_t*)(((unsigned char*)kin(41 + z)) + WS_S5B); const bf16_t* SCm = (const bf16_t*)(((unsigned char*)kin(41 + z)) + WS_S5C);
    float2* E = (float2*)(((unsigned char*)kin(41 + z)) + WS_S5E);
    for (int it = obid(); it < nitems; it += gridDim.x) {
        const int sc = it % nsc; int r = it / nsc; const int oct = r & 7, dir = (r >> 3) & 1, sq = r >> 4;
        if (pass == 1 && sc == nsc - 1) continue;
        const int G = oct * 8 + w, pp = lane;
        const float2 ab = AB[(dir * 64 + G) * 64 + pp];
        bf16x8 bx[8], by[4];
        const bf16x8 zero8 = (bf16x8){0, 0, 0, 0, 0, 0, 0, 0};
#pragma unroll
        for (int ct = 0; ct < 8; ++ct) bx[ct] = quad < 2 ? *(const bf16x8*)(SB + ((size_t)(dir * 64 + G) * 128 + ct * 16 + l15) * 16 + quad * 8) : zero8;
#pragma unroll
        for (int ks = 0; ks < 4; ++ks) by[ks] = *(const bf16x8*)(SCm + ((size_t)G * 16 + l15) * 128 + ks * 32 + quad * 8);
        float hre = 0.f, him = 0.f;
        if (pass == 2 && !ctx) {
            const int b = (seg - 1) * 2 + sq;
            hre = kin(3 + z)[((((size_t)b * 4 + l) * 2 + dir) * 64 + G) * 64 + pp]; him = kin(4 + z)[((((size_t)b * 4 + l) * 2 + dir) * 64 + G) * 64 + pp];
            if (sc > 0) { float pr = ab.x, pi = ab.y;
                for (int s = 0; s < 9; ++s) { const float nr = pr * pr - pi * pi, ni = 2.f * pr * pi; pr = nr; pi = ni; }
                for (int j2 = 0; j2 < sc; ++j2) { const float2 e = E[(size_t)(it - sc + j2) * 512 + tid]; const float nr = pr * hre - pi * him + e.x, ni = pr * him + pi * hre + e.y; hre = nr; him = ni; } }
        }
        bf16_t* Yg = (bf16_t*)(((unsigned char*)kin(41 + z)) + (dir ? WS_YSB : WS_YSF));
        const int rsgn = dir ? -1 : 1;
        const int rb0 = sq * T + (dir ? (T - 1 - sc * Lsc) : sc * Lsc);
        const int ut = lane >> 2, uc = (lane & 3) * 4;
        const bf16_t* up = PROJ + (size_t)(rb0 + rsgn * ut) * LDP + CU + G * 16 + uc;
        const long ustep = (long)rsgn * 16 * LDP;
        u32x2 ucur = *(const u32x2*)up;
        for (int sb = 0; sb < nsub; ++sb) {
            const int rbase = rb0 + rsgn * sb * 16;
            *(u32x2*)&UL[ut * 24 + uc] = ucur;
            if (sb + 1 < nsub) ucur = *(const u32x2*)(up + (long)(sb + 1) * ustep);
            WSYNC();
            { const bf16x8 a = quad < 2 ? *(const bf16x8*)&UL[l15 * 24 + quad * 8] : zero8;
#pragma unroll
                for (int ct = 0; ct < 8; ++ct) { f32x4 x4 = MFMA16(a, bx[ct], ((f32x4){0.f, 0.f, 0.f, 0.f}));
#pragma unroll
                    for (int j = 0; j < 4; ++j) X[(quad * 4 + j) * 132 + ct * 16 + l15] = x4[j]; } }
            WSYNC();
#pragma unroll
            for (int t = 0; t < 16; ++t) { const float xr = X[t * 132 + pp], xi = X[t * 132 + 64 + pp];
                const float nr = ab.x * hre - ab.y * him + xr, ni = ab.x * him + ab.y * hre + xi; hre = nr; him = ni;
                if (pass == 2) { H[t * 136 + pp] = f2bf(hre); H[t * 136 + 64 + pp] = f2bf(him); } }
            WSYNC();
            if (pass == 2) { f32x4 y4 = (f32x4){0.f, 0.f, 0.f, 0.f};
#pragma unroll
                for (int ks = 0; ks < 4; ++ks) { const bf16x8 a = *(const bf16x8*)&H[l15 * 136 + ks * 32 + quad * 8]; y4 = MFMA16(a, by[ks], y4); }
#pragma unroll
                for (int j = 0; j < 4; ++j) Yg[(size_t)(rbase + rsgn * (quad * 4 + j)) * 1024 + G * 16 + l15] = f2bf(y4[j]); }
            WSYNC();
        }
        if (pass == 1) E[(size_t)it * 512 + tid] = make_float2(hre, him);
        else if (ctx) { const size_t o = ((((size_t)sq * 4 + l) * 2 + dir) * 64 + G) * 64 + pp; ((float*)kin(40 + z))[OUT_S5RE + o] = hre; ((float*)kin(40 + z))[OUT_S5IM + o] = him; }
    }
    __syncthreads();
}

__device__ __forceinline__ void lru_scan(const Params& p, int l, int seg, int pass) {
    const int z = ozero();
    const bool ctx = (seg == 0);
    const int T = ctx ? 256 : 4096, nseq = ctx ? 32 : 2, nsc = ctx ? 1 : 16;
    if (pass == 1 && nsc == 1) return;
    const int n = nseq * 2 * nsc * 1536;
    const unsigned* LAB = (const unsigned*)(((unsigned char*)kin(41 + z)) + WS_LAB); float2* LRC = (float2*)(((unsigned char*)kin(41 + z)) + WS_LRC);
    const int per = (n + (int)gridDim.x - 1) / (int)gridDim.x;
    const int lt = otid();
    for (int idx = obid() * per + lt; lt < per && idx < n; idx += n) {
        const int ch = idx % 1536; int r = idx / 1536; const int sc = r % nsc; r /= nsc; const int dir = r & 1, sq = r >> 1;
        if (pass == 1 && sc == nsc - 1) continue;
        const int pos0 = sc * 256;
        const int rbase = sq * T + (dir ? (T - 1 - pos0) : pos0); const int rsgn = dir ? -1 : 1;
        const unsigned* lp = LAB + ((size_t)rbase * 2 + dir) * 1536 + ch; const long lstep = (long)rsgn * 3072;
        float h = 0.f;
        if (pass == 1) { float sl = 0.f;
            for (int t0 = 0; t0 < 256; t0 += 16) { unsigned wv[16];
#pragma unroll
                for (int i = 0; i < 16; ++i) wv[i] = lp[(long)(t0 + i) * lstep];
#pragma unroll
                for (int i = 0; i < 16; ++i) { const float la = bflo(wv[i]), b = bfhi(wv[i]); sl += la; h = __expf(la) * h + b; } }
            LRC[idx] = make_float2(sl, h);
        } else {
            if (!ctx) { const int b = (seg - 1) * 2 + sq; h = kin(5 + z)[(((size_t)b * 4 + l) * 2 + dir) * 1536 + ch];
                for (int j = 0; j < sc; ++j) { const float2 e = LRC[idx - (sc - j) * 1536]; h = __expf(e.x) * h + e.y; } }
            bf16_t* Hg = (bf16_t*)(((unsigned char*)kin(41 + z)) + (dir ? WS_HB : WS_HF)) + (size_t)rbase * 1536 + ch; const long hstep = (long)rsgn * 1536;
            for (int t0 = 0; t0 < 256; t0 += 16) { unsigned wv[16];
#pragma unroll
                for (int i = 0; i < 16; ++i) wv[i] = lp[(long)(t0 + i) * lstep];
#pragma unroll
                for (int i = 0; i < 16; ++i) { const float la = bflo(wv[i]), b = bfhi(wv[i]); h = __expf(la) * h + b; Hg[(long)(t0 + i) * hstep] = f2bf(h); } }
            if (ctx) ((float*)kin(40 + z))[OUT_LRU + (((size_t)sq * 4 + l) * 2 + dir) * 1536 + ch] = h;
        }
    }
}

__device__ __forceinline__ void phase_post(const Params& p, int l) {
    const int z = ozero();
    unsigned char* ws = (unsigned char*)kin(41 + z);
    const int tid = otid(), gt = obid() * 512 + tid, gs = gridDim.x * 512;
    const bf16_t* PROJ = (const bf16_t*)(ws + WS_PROJ);
    {
        const bf16_t* OF = (const bf16_t*)(ws + WS_OF); const bf16_t* OB = (const bf16_t*)(ws + WS_OB); bf16_t* YG = (bf16_t*)(ws + WS_YG);
        const float* ng = kin(13 + z) + (size_t)l * 1024;
        const int sub = tid & 31, ngrp = gs >> 5;
#pragma unroll 2
        for (int g = gt >> 5; g < SEG * 4; g += ngrp) { const int row = g >> 2, c = (g & 3) * 256 + sub * 8;
            const u32x4 oa = *(const u32x4*)(OF + (size_t)row * 1024 + c), ob = *(const u32x4*)(OB + (size_t)row * 1024 + c);
            float fa8[8], fb8[8]; unpack8(oa, fa8); unpack8(ob, fb8);
            const f32x4 a0 = (f32x4){fa8[0], fa8[1], fa8[2], fa8[3]}, a1 = (f32x4){fa8[4], fa8[5], fa8[6], fa8[7]};
            const f32x4 b0 = (f32x4){fb8[0], fb8[1], fb8[2], fb8[3]}, b1 = (f32x4){fb8[4], fb8[5], fb8[6], fb8[7]};
            const u32x4 rw = *(const u32x4*)(PROJ + (size_t)row * LDP + CR + c);
            const f32x4 g0 = *(const f32x4*)(ng + c), g1 = *(const f32x4*)(ng + c + 4);
            f32x4 o0 = a0 + b0, o1 = a1 + b1;
            float sm = (o0[0] + o0[1] + o0[2] + o0[3]) + (o1[0] + o1[1] + o1[2] + o1[3]);
#pragma unroll
            for (int o = 16; o > 0; o >>= 1) sm += __shfl_xor(sm, o);
            const float mu = sm * (1.f / 256.f);
            o0 = o0 - mu; o1 = o1 - mu;
            float sq = (o0[0] * o0[0] + o0[1] * o0[1] + o0[2] * o0[2] + o0[3] * o0[3]) + (o1[0] * o1[0] + o1[1] * o1[1] + o1[2] * o1[2] + o1[3] * o1[3]);
#pragma unroll
            for (int o = 16; o > 0; o >>= 1) sq += __shfl_xor(sq, o);
            const float rs = rsqrtf(sq * (1.f / 256.f) + 1e-5f);
            float r[8], v[8]; unpack8(rw, r);
#pragma unroll
            for (int j = 0; j < 4; ++j) { v[j] = o0[j] * rs * g0[j] * (r[j] * sigm(r[j])); v[4 + j] = o1[j] * rs * g1[j] * (r[4 + j] * sigm(r[4 + j])); }
            *(u32x4*)(YG + (size_t)row * 1024 + c) = pack8(v); }
    }
    {
        const bf16_t* YSF = (const bf16_t*)(ws + WS_YSF); const bf16_t* YSB = (const bf16_t*)(ws + WS_YSB); bf16_t* YSA = (bf16_t*)(ws + WS_YSA);
        const float* sd = kin(21 + z) + (size_t)l * 1024;
#pragma unroll 2
        for (int i = gt; i < SEG * 128; i += gs) { const int row = i >> 7, c = (i & 127) * 8;
            const u32x4 a = *(const u32x4*)(YSF + (size_t)row * 1024 + c), b = *(const u32x4*)(YSB + (size_t)row * 1024 + c), u = *(const u32x4*)(PROJ + (size_t)row * LDP + CU + c);
            const f32x4 d0 = *(const f32x4*)(sd + c), d1 = *(const f32x4*)(sd + c + 4);
            float fa[8], fb[8], fu[8], v[8]; unpack8(a, fa); unpack8(b, fb); unpack8(u, fu);
#pragma unroll
            for (int j = 0; j < 8; ++j) v[j] = gelu_(fa[j] + fb[j] + (j < 4 ? d0[j] : d1[j - 4]) * fu[j]);
            *(u32x4*)(YSA + (size_t)row * 1024 + c) = pack8(v); }
    }
    {
        const bf16_t* HF = (const bf16_t*)(ws + WS_HF); const bf16_t* HB = (const bf16_t*)(ws + WS_HB); bf16_t* YL = (bf16_t*)(ws + WS_YL);
#pragma unroll 2
        for (int i = gt; i < SEG * 192; i += gs) { const int row = i / 192, c = (i % 192) * 8;
            const u32x4 a = *(const u32x4*)(HF + (size_t)row * 1536 + c), b = *(const u32x4*)(HB + (size_t)row * 1536 + c), y = *(const u32x4*)(PROJ + (size_t)row * LDP + CLY + c);
            float fa[8], fb[8], fy[8], v[8]; unpack8(a, fa); unpack8(b, fb); unpack8(y, fy);
#pragma unroll
            for (int j = 0; j < 8; ++j) v[j] = (fa[j] + fb[j]) * gelu_(fy[j]);
            *(u32x4*)(YL + (size_t)row * 1536 + c) = pack8(v); }
    }
}

__device__ __forceinline__ void phase_ln(const Params& p, int seg, int nrows, bool two, const float* g, const float* b, const float* modl  , int shift_off, int scale_off, bf16_t* hdst  ) {
    const int z = ozero();
    const int lane = otid() & 63, wv = obid() * 8 + (otid() >> 6), nw = gridDim.x * 8;
    const float* PRE = (const float*)(((unsigned char*)kin(41 + z)) + WS_PRE);
    float* X = ((float*)kin(40 + z)) + (size_t)seg * SEG * 1024;
    for (int row0 = wv * 2; row0 < nrows; row0 += nw * 2) {
        f32x4 v[2][4];
#pragma unroll
        for (int rr = 0; rr < 2; ++rr)
#pragma unroll
            for (int q = 0; q < 4; ++q) { v[rr][q] = *(const f32x4*)(PRE + (size_t)(row0 + rr) * 1024 + q * 256 + lane * 4); if (two) v[rr][q] += *(const f32x4*)(PRE + (size_t)SEG * 1024 + (size_t)(row0 + rr) * 1024 + q * 256 + lane * 4); }
#pragma unroll
        for (int rr = 0; rr < 2; ++rr) { const int row = row0 + rr; float s = 0.f;
#pragma unroll
            for (int q = 0; q < 4; ++q) s += v[rr][q][0] + v[rr][q][1] + v[rr][q][2] + v[rr][q][3];
            const float mu = wsum(s) * (1.f / 1024.f); float ss = 0.f;
#pragma unroll
            for (int q = 0; q < 4; ++q) { v[rr][q] = v[rr][q] - mu; ss += v[rr][q][0] * v[rr][q][0] + v[rr][q][1] * v[rr][q][1] + v[rr][q][2] * v[rr][q][2] + v[rr][q][3] * v[rr][q][3]; }
            const float rs = rsqrtf(wsum(ss) * (1.f / 1024.f) + 1e-5f);
            const float* mp = modl ? modl + (size_t)modrow_of(seg, row) * 6144 : nullptr;
#pragma unroll
            for (int q = 0; q < 4; ++q) { const int c = q * 256 + lane * 4;
                const f32x4 y = v[rr][q] * rs * *(const f32x4*)(g + c) + *(const f32x4*)(b + c);
                *(f32x4*)(X + (size_t)row * 1024 + c) = y;
                if (mp) { const f32x4 sh = *(const f32x4*)(mp + shift_off + c), sc = *(const f32x4*)(mp + scale_off + c);
                    u32x2 w; w.x = pk2(y[0] * (1.f + sc[0]) + sh[0], y[1] * (1.f + sc[1]) + sh[1]); w.y = pk2(y[2] * (1.f + sc[2]) + sh[2], y[3] * (1.f + sc[3]) + sh[3]);
                    *(u32x2*)(hdst + (size_t)row * 1024 + c) = w; } } }
    }
}

__device__ __forceinline__ void phase_mconv(const Params& p, int seg) {
    const int z = ozero();
    unsigned char* ws = (unsigned char*)kin(41 + z);
    const float* M1 = (const float*)(ws + WS_MRG); const float* M2 = (const float*)(ws + WS_MRG2); bf16_t* MG = (bf16_t*)(ws + WS_MG2) + (size_t)(seg & 1) * SEG * 1024;
    const int gs = gridDim.x * 512;
#pragma unroll 2
    for (int i = obid() * 512 + otid(); i < SEG * 128; i += gs) { const size_t o = (size_t)i * 8;
        const f32x4 a0 = *(const f32x4*)(M1 + o), a1 = *(const f32x4*)(M1 + o + 4), b0 = *(const f32x4*)(M2 + o), b1 = *(const f32x4*)(M2 + o + 4);
        float v[8];
#pragma unroll
        for (int j = 0; j < 4; ++j) { v[j] = a0[j] + b0[j]; v[4 + j] = a1[j] + b1[j]; }
        *(u32x4*)(MG + o) = pack8(v); }
}

#define XB_TMO      128
#define XB_XCNT(j)  (256  + 64 * (j))
#define XB_XSUB(j)  (1280 + 64 * (j))
#define XB_XGEN(j)  (2304 + 64 * (j))
#define XB_TOP      3328
#define XB_TOPGEN   3392
#define XCD_BAR_WORDS 3456
#define XB_SPIN_CAP (1u << 20)
__device__ __forceinline__ unsigned xb_ld(unsigned* p)              { return __hip_atomic_load(p, __ATOMIC_RELAXED, __HIP_MEMORY_SCOPE_AGENT); }
__device__ __forceinline__ unsigned xb_add(unsigned* p, unsigned v) { return __hip_atomic_fetch_add(p, v, __ATOMIC_RELAXED, __HIP_MEMORY_SCOPE_AGENT); }
__device__ __forceinline__ unsigned xb_xcc_id() { return (unsigned)__builtin_amdgcn_s_getreg((3 << 11) | 20) & 0xFu; }
#define XB_SPIN(cond, bar) do { unsigned _sp = 0; while (cond) { __builtin_amdgcn_s_sleep(1); \
    if ((++_sp & 255u) == 0u) { if (xb_ld(&(bar)[XB_TMO])) break; if (_sp > XB_SPIN_CAP) { atomicAdd(&(bar)[XB_TMO], 1u); break; } } } } while (0)
struct XcdBarrier { unsigned* bar; unsigned x; volatile LAS unsigned* st; };
__device__ __forceinline__ XcdBarrier xcd_barrier_post(unsigned* bar, volatile LAS unsigned* st) {
    XcdBarrier b; b.bar = bar; b.x = xb_xcc_id(); b.st = st;
    if (threadIdx.x == 0) (void)xb_add(&bar[XB_XCNT(b.x)], 1u);
    return b;
}
__device__ __forceinline__ void xcd_barrier_complete(unsigned* bar, unsigned x, unsigned& nloc, unsigned& nx) {
    const unsigned G = gridDim.x * gridDim.y * gridDim.z;
    unsigned sum, cnt, mine, sp = 0u;
    for (;;) {
        sum = 0u; cnt = 0u; mine = 0u;
#pragma unroll
        for (unsigned j = 0; j < 16; ++j) { const unsigned c = xb_ld(&bar[XB_XCNT(j)]); sum += c; cnt += (c > 0u) ? 1u : 0u; mine = (j == x) ? c : mine; }
        if (sum == G) break;
        __builtin_amdgcn_s_sleep(1);
        if ((++sp & 255u) == 0u) { if (xb_ld(&bar[XB_TMO])) break; if (sp > XB_SPIN_CAP) { atomicAdd(&bar[XB_TMO], 1u); break; } }
    }
    nloc = mine > 0u ? mine : 1u; nx = cnt > 0u ? cnt : 1u;
}
__device__ __forceinline__ void xcd_barrier(const XcdBarrier& b) {
    asm volatile("s_waitcnt vmcnt(0)" ::: "memory");
    __syncthreads();
    if (threadIdx.x == 0) {
        unsigned* bar = b.bar;
        __builtin_amdgcn_s_waitcnt(0);
        unsigned nloc = b.st[0], nx = b.st[1];
        if (nloc == 0u) { xcd_barrier_complete(bar, b.x, nloc, nx); b.st[0] = nloc; b.st[1] = nx; }
        const unsigned old = xb_add(&bar[XB_XSUB(b.x)], 1u);
        const unsigned gen = old / nloc;
        if (old + 1u == (gen + 1u) * nloc) {
            __builtin_amdgcn_fence(__ATOMIC_RELEASE, "agent");
            asm volatile("s_waitcnt vmcnt(0)" ::: "memory");
            const unsigned og = xb_add(&bar[XB_TOP], 1u);
            const unsigned tg = og / nx;
            if (og + 1u == (tg + 1u) * nx) xb_add(&bar[XB_TOPGEN], 1u);
            else XB_SPIN(xb_ld(&bar[XB_TOPGEN]) == tg, bar);
            __builtin_amdgcn_fence(__ATOMIC_ACQUIRE, "agent");
            xb_add(&bar[XB_XGEN(b.x)], 1u);
            asm volatile("s_waitcnt vmcnt(0)" ::: "memory");
        } else {
            XB_SPIN(xb_ld(&bar[XB_XGEN(b.x)]) == gen, bar);
            __builtin_amdgcn_fence(__ATOMIC_ACQUIRE, "agent");
            asm volatile("s_waitcnt vmcnt(0)" ::: "memory");
        }
    }
    __syncthreads();
}

__global__ void __launch_bounds__(512, 2) fwd_megakernel(Params p) {
    extern __shared__ __attribute__((aligned(16))) unsigned char lds[];
    cg::grid_group grid = cg::this_grid();
    volatile LAS unsigned* xst = (volatile LAS unsigned*)(lds + 131072);
    if (threadIdx.x == 0) { xst[0] = 0u; xst[1] = 0u; }
    __syncthreads();
    XcdBarrier xb = xcd_barrier_post((unsigned*)(p.ws + WS_BAR), xst);
    phase_mods(p, lds);
    grid.sync();
    phase_xinit(p);
    for (int l = 0; l < 4; ++l) {
        phase_layer_setup(p, l, lds);
        xcd_barrier(xb);
        for (int seg = 0; seg < NSEG; ++seg) {
            const int z = ozero();
            unsigned char* ws = (unsigned char*)kin(41 + z);
            const float* modl = (const float*)(ws + WS_MOD) + (size_t)l * 9 * 6144;
            { EpiProj E; E.O = (bf16_t*)(ws + WS_PROJ); E.col_off = 0;
                run_gemm(lds, (const bf16_t*)(ws + WS_HA) + (size_t)seg * SEG * 1024, 1024, (const bf16_t*)(ws + WS_WIN), 1024, SEG, 10240, 1024, 1, 0, E); }
            xcd_barrier(xb);
            if (seg & 1) phase_mconv(p, seg - 1);
            phase_conv(p, l, seg);
            if ((obid() & 7) == 7) {
                EpiProj E; E.O = (bf16_t*)(ws + WS_PROJ); E.col_off = CGLR;
                run_gemm_sub(lds, (const bf16_t*)(ws + WS_HA) + (size_t)seg * SEG * 1024, 1024, (const bf16_t*)(ws + WS_WIN) + (size_t)CGLR * 1024, 1024, SEG, 256, 1024, (int)gridDim.x >> 3, obid() >> 3, E);
            } else s5_items(p, l, seg, 1, lds);
            xcd_barrier(xb);
            { EpiLruGate E; E.XC = (const bf16_t*)(ws + WS_XC); E.LAB = (unsigned*)(ws + WS_LAB); E.cl = (const float*)(ws + WS_LCL); E.ba = kin(26 + z) + (size_t)l * 3072; E.bi = kin(28 + z) + (size_t)l * 3072;
                run_gemm(lds, (const bf16_t*)(ws + WS_XC), 1536, (const bf16_t*)(ws + WS_WLRU), 256, SEG, 6144, 256, 12, 512, E); }
            xcd_barrier(xb);
            if (seg != 0) {
                gla_items(p, l, seg, 1, lds);
                s5_items(p, l, seg, 2, lds);
                lru_scan(p, l, seg, 1);
                xcd_barrier(xb);
            }
            gla_items(p, l, seg, 2, lds);
            if (seg == 0) s5_items(p, l, seg, 2, lds);
            lru_scan(p, l, seg, 2);
            xcd_barrier(xb);
            phase_post(p, l);
            xcd_barrier(xb);
            { const int bid = obid(), half = (int)gridDim.x >> 1;
                if (bid < half) { EpiGlu E; E.YSA = (const bf16_t*)(ws + WS_YSA); E.YS5 = (bf16_t*)(ws + WS_YS5);
                    run_gemm_sub(lds, (const bf16_t*)(ws + WS_YSA), 1024, (const bf16_t*)(ws + WS_WGLU), 1024, SEG, 1024, 1024, half, bid, E); }
                else { EpiMerge E; E.MRG = (float*)(ws + WS_MRG); E.MERGED = nullptr; E.mode = 0; E.G = (const bf16_t*)(ws + WS_PROJ) + CG;
                    run_gemm_sub(lds, (const bf16_t*)(ws + WS_YG), 1024, (const bf16_t*)(ws + WS_WBG), 1024, SEG, 1024, 1024, (int)gridDim.x - half, bid - half, E); } }
            xcd_barrier(xb);
            { const int bid = obid(), half = (int)gridDim.x >> 1;
                if (bid < half) { EpiMerge E; E.MRG = (float*)(ws + WS_MRG2); E.MERGED = nullptr; E.mode = 0; E.G = (const bf16_t*)(ws + WS_PROJ) + CG + 1024;
                    run_gemm_sub(lds, (const bf16_t*)(ws + WS_YS5), 1024, (const bf16_t*)(ws + WS_WBS), 1024, SEG, 1024, 1024, half, bid, E); }
                else { EpiMerge E; E.MRG = (float*)(ws + WS_MRG); E.MERGED = nullptr; E.mode = 1; E.G = (const bf16_t*)(ws + WS_PROJ) + CG + 2048;
                    run_gemm_sub(lds, (const bf16_t*)(ws + WS_YL), 1536, (const bf16_t*)(ws + WS_WBL), 1536, SEG, 1024, 1536, (int)gridDim.x - half, bid - half, E); } }
            xcd_barrier(xb);
            if ((seg & 1) || seg == NSEG - 1) {
                phase_mconv(p, seg);
                xcd_barrier(xb);
            }
            if ((seg & 1) || seg == NSEG - 1) {
                const int g0 = seg & ~1, M = (seg - g0 + 1) * SEG;
                const bool lone = (M == SEG);
                const int bid = obid(), half = (int)gridDim.x >> 1;
                if (!lone) { EpiRes E; E.X = (const float*)kin(40 + z) + (size_t)g0 * SEG * 1024; E.gate = modl + 2048; E.seg = g0; E.PRE = (float*)(ws + WS_PRE); E.xs = ALPHA;
                    run_gemm(lds, (const bf16_t*)(ws + WS_MG2), 1024, (const bf16_t*)(ws + WS_WOUT), 1024, M, 1024, 1024, 1, 0, E); }
                else { const int hi = bid >= half ? 1 : 0; EpiRes E; E.X = (const float*)kin(40 + z) + (size_t)g0 * SEG * 1024; E.gate = modl + 2048; E.seg = g0; E.PRE = (float*)(ws + WS_PRE) + (size_t)hi * SEG * 1024; E.xs = hi ? 0.f : ALPHA;
                    run_gemm_sub(lds, (const bf16_t*)(ws + WS_MG2) + hi * 512, 1024, (const bf16_t*)(ws + WS_WOUT) + hi * 512, 1024, M, 1024, 512, hi ? (int)gridDim.x - half : half, hi ? bid - half : bid, E); }
                xcd_barrier(xb);
                phase_ln(p, g0, M, lone, kin(34 + z) + (size_t)l * 1024, kin(35 + z) + (size_t)l * 1024, modl, 3072, 4096, (bf16_t*)(ws + WS_H2));
                xcd_barrier(xb);
                { EpiRelu2 E; E.O = (bf16_t*)(ws + WS_HID);
                    run_gemm(lds, (const bf16_t*)(ws + WS_H2), 1024, (const bf16_t*)(ws + WS_WMI), 1024, M, 4096, 1024, 1, 0, E); }
                xcd_barrier(xb);
                if (!lone) { EpiRes E; E.X = (const float*)kin(40 + z) + (size_t)g0 * SEG * 1024; E.gate = modl + 5120; E.seg = g0; E.PRE = (float*)(ws + WS_PRE); E.xs = ALPHA;
                    run_gemm(lds, (const bf16_t*)(ws + WS_HID), 4096, (const bf16_t*)(ws + WS_WMO), 4096, M, 1024, 4096, 1, 0, E); }
                else { const int hi = bid >= half ? 1 : 0; EpiRes E; E.X = (const float*)kin(40 + z) + (size_t)g0 * SEG * 1024; E.gate = modl + 5120; E.seg = g0; E.PRE = (float*)(ws + WS_PRE) + (size_t)hi * SEG * 1024; E.xs = hi ? 0.f : ALPHA;
                    run_gemm_sub(lds, (const bf16_t*)(ws + WS_HID) + hi * 2048, 4096, (const bf16_t*)(ws + WS_WMO) + hi * 2048, 4096, M, 1024, 2048, hi ? (int)gridDim.x - half : half, hi ? bid - half : bid, E); }
                xcd_barrier(xb);
                phase_ln(p, g0, M, lone, kin(36 + z) + (size_t)l * 1024, kin(37 + z) + (size_t)l * 1024, l < 3 ? modl + 9 * 6144 : nullptr, 0, 1024, (bf16_t*)(ws + WS_HA) + (size_t)g0 * SEG * 1024);
            }
        }
    }
}

extern "C" void kernel_launch(void* const* d_in, const int* in_sizes, int n_in, void* d_out, int out_size, void* d_ws, size_t ws_size, hipStream_t stream) {
    constexpr int kLds = 131072 + 16;
    static int grid_blocks = 0;
    if (grid_blocks == 0) {
        if (n_in != 40 || ws_size < WS_END) { fprintf(stderr, "kernel_launch: n_in %d ws %zu need %zu\n", n_in, ws_size, (size_t)WS_END); grid_blocks = -1; return; }
        int dev = 0, cus = 0, per_cu = 0;
        hipGetDevice(&dev);
        hipDeviceGetAttribute(&cus, hipDeviceAttributeMultiprocessorCount, dev);
        hipFuncSetAttribute((const void*)fwd_megakernel, hipFuncAttributeMaxDynamicSharedMemorySize, kLds);
        hipOccupancyMaxActiveBlocksPerMultiprocessor(&per_cu, (const void*)fwd_megakernel, 512, kLds);
        if (per_cu < 1) per_cu = 1;
        grid_blocks = cus * per_cu;
        if (grid_blocks > 256) grid_blocks = 256;
    }
    if (grid_blocks < 0) return;
    Params p{};
    for (int i = 0; i < 40; ++i) p.in[i] = (const float*)d_in[i];
    p.out = (float*)d_out; p.ws = (unsigned char*)d_ws;
    (void)hipMemsetAsync((unsigned char*)d_ws + WS_BAR, 0, 16384, stream);
    void* args[] = {&p};
    hipError_t e = hipLaunchCooperativeKernel((const void*)fwd_megakernel, dim3(grid_blocks), dim3(512), args, kLds, stream);
    if (e != hipSuccess) fprintf(stderr, "cooperative launch failed: %s (grid %d)\n", hipGetErrorString(e), grid_blocks);
}
```

```cpp
#include <hip/hip_runtime.h>
#include <hip/hip_cooperative_groups.h>
#include <cstdio>
namespace cg = cooperative_groups;

typedef unsigned short bf16_t;
typedef short bf16x8 __attribute__((ext_vector_type(8)));
typedef float f32x4 __attribute__((ext_vector_type(4)));
typedef unsigned u32x4 __attribute__((ext_vector_type(4)));
typedef unsigned u32x2 __attribute__((ext_vector_type(2)));
#define LAS __attribute__((address_space(3)))

constexpr int D = 1024, SEG = 8192, NSEG = 5, LDP = 10496;
constexpr int CQ = 0, CK = 512, CV = 1024, CR = 2048, CU = 3072, CLX = 4096, CLY = 5632, CG = 7168, CGLR = 10240;
constexpr size_t OUT_GLA = 41943040, OUT_S5RE = OUT_GLA + 33554432, OUT_S5IM = OUT_S5RE + 1048576, OUT_LRU = OUT_S5IM + 1048576;
constexpr float ALPHA = 1.681792830507429f;

constexpr size_t WS_MOD  = 0;
constexpr size_t WS_S5AB = WS_MOD + 4 * 9 * 6144 * 4;
constexpr size_t WS_S5B  = WS_S5AB + 2 * 64 * 64 * 8;
constexpr size_t WS_S5C  = WS_S5B + 2 * 64 * 128 * 16 * 2;
constexpr size_t WS_LCL  = WS_S5C + 64 * 16 * 128 * 2;
constexpr size_t WS_WIN  = WS_LCL + 2 * 1536 * 4;
constexpr size_t WS_WGLU = WS_WIN + (size_t)10496 * 1024 * 2;
constexpr size_t WS_WLRU = WS_WGLU + (size_t)1024 * 1024 * 2;
constexpr size_t WS_WBG  = WS_WLRU + (size_t)6144 * 256 * 2;
constexpr size_t WS_WBS  = WS_WBG + (size_t)1024 * 1024 * 2;
constexpr size_t WS_WBL  = WS_WBS + (size_t)1024 * 1024 * 2;
constexpr size_t WS_WOUT = WS_WBL + (size_t)1024 * 1536 * 2;
constexpr size_t WS_WMI  = WS_WOUT + (size_t)1024 * 1024 * 2;
constexpr size_t WS_WMO  = WS_WMI + (size_t)4096 * 1024 * 2;
constexpr size_t WS_HA   = WS_WMO + (size_t)4096 * 1024 * 2;
constexpr size_t WS_PROJ = WS_HA + (size_t)40960 * 1024 * 2;
constexpr size_t WS_OF   = WS_PROJ + (size_t)SEG * LDP * 2;
constexpr size_t WS_OB   = WS_OF + (size_t)SEG * 1024 * 4;
constexpr size_t WS_YSF  = WS_OB + (size_t)SEG * 1024 * 4;
constexpr size_t WS_YSB  = WS_YSF + (size_t)SEG * 1024 * 2;
constexpr size_t WS_XC   = WS_YSB + (size_t)SEG * 1024 * 2;
constexpr size_t WS_LAB  = WS_XC + (size_t)SEG * 1536 * 2;
constexpr size_t WS_HF   = WS_LAB + (size_t)SEG * 3072 * 4;
constexpr size_t WS_HB   = WS_HF + (size_t)SEG * 1536 * 2;
constexpr size_t WS_YG   = WS_HB + (size_t)SEG * 1536 * 2;
constexpr size_t WS_YSA  = WS_YG + (size_t)SEG * 1024 * 2;
constexpr size_t WS_GST  = WS_YSA + (size_t)SEG * 1024 * 2;
constexpr size_t WS_GLT  = WS_GST + (size_t)256 * 16384 * 4;
constexpr size_t WS_S5E  = WS_GLT + 256 * 128 * 4;
constexpr size_t WS_LRC  = WS_S5E + 256 * 512 * 8;
constexpr size_t WS_MG2  = WS_LRC + 98304 * 8;
constexpr size_t WS_BAR  = WS_MG2 + (size_t)2 * SEG * 1024 * 2;
constexpr size_t WS_END  = WS_BAR + 16384;
constexpr size_t WS_HID = WS_PROJ, WS_MRG = WS_OF, WS_MRG2 = WS_OB, WS_PRE = WS_OF  , WS_YS5 = WS_YSF, WS_YL = WS_XC, WS_H2 = WS_YG, WS_MERGED = WS_YSA;

struct Params { const float* in[40]; float* out; unsigned char* ws; };

typedef __bf16 nbf16x2 __attribute__((ext_vector_type(2)));
typedef float nf32x2 __attribute__((ext_vector_type(2)));
__device__ __forceinline__ bf16_t f2bf(float f) { return __builtin_bit_cast(unsigned short, (__bf16)f); }
__device__ __forceinline__ float bf2f(bf16_t b) { return __uint_as_float(((unsigned)b) << 16); }
__device__ __forceinline__ unsigned pk2(float lo, float hi) { const nf32x2 v = {lo, hi}; return __builtin_bit_cast(unsigned, __builtin_convertvector(v, nbf16x2)); }
__device__ __forceinline__ float bflo(unsigned w) { return __uint_as_float(w << 16); }
__device__ __forceinline__ float bfhi(unsigned w) { return __uint_as_float(w & 0xFFFF0000u); }
__device__ __forceinline__ float sigm(float x) { return __builtin_amdgcn_rcpf(1.f + __expf(-x)); }
__device__ __forceinline__ float tanh_(float x) { float e = __expf(2.f * x); return 1.f - 2.f * __builtin_amdgcn_rcpf(e + 1.f); }
__device__ __forceinline__ float gelu_(float x) { return 0.5f * x * (1.f + tanh_(0.7978845608028654f * (x + 0.044715f * x * x * x))); }
__device__ __forceinline__ float log1p_(float e) { return e < 0.01f ? e * (1.f - e * (0.5f - e * (1.f / 3.f))) : __logf(1.f + e); }
__device__ __forceinline__ float logsig_(float x) { return fminf(x, 0.f) - log1p_(__expf(-fabsf(x))); }
__device__ __forceinline__ float expm1_(float x) { return fabsf(x) < 0.1f ? x * (1.f + x * (0.5f + x * (1.f / 6.f + x * (1.f / 24.f + x * (1.f / 120.f))))) : __expf(x) - 1.f; }
__device__ __forceinline__ float wsum(float v) { for (int o = 32; o > 0; o >>= 1) v += __shfl_xor(v, o); return v; }
__device__ __forceinline__ int otid() { int t = threadIdx.x; asm volatile("" : "+v"(t)); return t; }
__device__ __forceinline__ int ozero() { int z = 0; asm volatile("" : "+s"(z)); return z; }
typedef const float* cfptr;
__device__ __forceinline__ cfptr kin(int i) { const __attribute__((address_space(4))) cfptr* ka = (const __attribute__((address_space(4))) cfptr*)__builtin_amdgcn_kernarg_segment_ptr(); return ka[i]; }
__device__ __forceinline__ int obid() { int b = blockIdx.x; asm volatile("" : "+s"(b)); return b; }
__device__ __forceinline__ int modrow_of(int seg, int row) { const int tok = seg * 8192 + row; return tok < 8192 ? 0 : 1 + ((tok - 8192) >> 12); }

namespace pg8 {
constexpr int BM = 256, BK = 64, HALF = 128, HTB = HALF * BK * 2, STAGE_BYTES = 8 * HTB, NXCD = 8, WGM = 8;
__host__ __device__ __forceinline__ int lds_byte(int r, int c) { const int st = (r >> 4) * 2 + (c >> 5), rr = r & 15, cc = c & 31, ob = rr * 64 + cc * 2; return st * 1024 + (ob ^ (((ob >> 9) & 1) << 5)); }
__host__ __device__ __forceinline__ void stage_rc(int b, int& R, int& C) { const int st = b / 1024, sb = b % 1024, swz = sb ^ (((sb >> 9) & 1) << 5); R = (st >> 1) * 16 + swz / 64; C = (st & 1) * 32 + (swz % 64) / 2; }
__host__ __device__ __forceinline__ int perm32(int rho) { const int n = rho >> 4, i = rho & 15; return 8 * (i >> 2) + 4 * n + (i & 3); }
struct Unit { int pm, pn; };
struct Gemm { const bf16_t* A; const bf16_t* Bt; int M, N, K, lda, ldb, ak_mod, ak_bytes; };
struct StaticOrder {
    int nM, nN, nwg, G, c;
    __device__ void init(int M, int N, int G_, int c_) { nM = M / BM; nN = N / BM; nwg = nM * nN; G = G_; c = c_; }
    __device__ bool next(int i, Unit& u) const {
        const long L = (long)i * G + c; if (L >= nwg) return false;
        int wgid = (int)L; { const int q = nwg / NXCD, r = nwg % NXCD, xcd = wgid % NXCD, off = wgid / NXCD; wgid = (xcd < r ? xcd * (q + 1) : r * (q + 1) + (xcd - r) * q) + off; }
        const int nig = WGM * nN, gid = wgid / nig, fm = gid * WGM, gsz = (nM - fm) < WGM ? (nM - fm) : WGM;
        u.pm = fm + ((wgid % nig) % gsz); u.pn = (wgid % nig) / gsz; return true;
    }
};
template <class Epi>
__device__ __forceinline__ void gemm_phase(LAS unsigned char* lds, const Gemm g, const StaticOrder& S, const Epi& E) {
    const int tid = otid(), wid = __builtin_amdgcn_readfirstlane(tid >> 6), lane = tid & 63, wr = wid >> 2, wc = wid & 3, fr = lane & 15, fq = lane >> 4;
    int K = g.K; asm volatile("" : "+s"(K)); const int nt = K / BK;
    unsigned voffA[2], voffB[2];
#pragma unroll
    for (int i = 0; i < 2; ++i) { int R, C; stage_rc(tid * 16 + i * 8192, R, C); const int Rb = Epi::PERM ? ((R & ~31) + perm32(R & 31)) : R;
        voffA[i] = (unsigned)(R * g.lda + C) * 2u; voffB[i] = (unsigned)(Rb * g.ldb + C) * 2u; }
    const size_t kstep = (size_t)(BK * 2);
    const size_t hA = (size_t)HALF * g.lda * 2, hB = (size_t)HALF * g.ldb * 2;
    const size_t tA = 2 * hA, tB = 2 * hB;
    const unsigned ldsw = (unsigned)wid * 1024u;
    const int aoff = lds_byte(wr * 64 + fr, fq * 8), boff = lds_byte(wc * 32 + fr, fq * 8);
#define PG8_SA(b, h) (((b) * 2 + (h)) * HTB)
#define PG8_SB(b, h) ((4 + (b) * 2 + (h)) * HTB)
#define PG8_STAGE(bufoff, gbase, voff) do { _Pragma("unroll") for (int _i = 0; _i < 2; ++_i) \
        __builtin_amdgcn_global_load_lds((const unsigned*)((const char*)(gbase) + (voff)[_i]), (LAS unsigned*)(lds + (bufoff) + ldsw + _i * 8192), 16, 0, 0); } while (0)
#define PG8_LDA(dst, b, h) do { _Pragma("unroll") for (int m = 0; m < 4; ++m) _Pragma("unroll") for (int k = 0; k < 2; ++k) dst[m][k] = *(const LAS bf16x8*)(lds + PG8_SA(b, h) + aoff + m * 2048 + k * 1024); } while (0)
#define PG8_LDB(dst, b, h) do { _Pragma("unroll") for (int n = 0; n < 2; ++n) _Pragma("unroll") for (int k = 0; k < 2; ++k) dst[n][k] = *(const LAS bf16x8*)(lds + PG8_SB(b, h) + boff + n * 2048 + k * 1024); } while (0)
#define PG8_MMA(ai, bj, At, Bt) do { __builtin_amdgcn_s_setprio(1); _Pragma("unroll") for (int m = 0; m < 4; ++m) _Pragma("unroll") for (int n = 0; n < 2; ++n) _Pragma("unroll") for (int k = 0; k < 2; ++k) \
        acc[ai][bj][m][n] = __builtin_amdgcn_mfma_f32_16x16x32_bf16(Bt[n][k], At[m][k], acc[ai][bj][m][n], 0, 0, 0); __builtin_amdgcn_s_setprio(0); } while (0)
#define PG8_WAIT_V(n) asm volatile("s_waitcnt vmcnt(" #n ")" ::: "memory")
#define PG8_WAIT_L(n) asm volatile("s_waitcnt lgkmcnt(" #n ")" ::: "memory")
#define PG8_BAR __builtin_amdgcn_s_barrier()
#define PG8_SCHED __builtin_amdgcn_sched_barrier(0)
#define PG8_UA(u) ((const char*)g.A + (size_t)(u).pm * tA + (size_t)(((u).pn % g.ak_mod) >> 1) * (size_t)g.ak_bytes)
    Unit cur, nxt; int ui = 0;
    if (!S.next(0, cur)) return;
    f32x4 acc[2][2][4][2];
#pragma unroll
    for (int a = 0; a < 2; ++a)
#pragma unroll
        for (int b = 0; b < 2; ++b)
#pragma unroll
            for (int m = 0; m < 4; ++m)
#pragma unroll
                for (int n = 0; n < 2; ++n) acc[a][b][m][n] = (f32x4){0.f, 0.f, 0.f, 0.f};
    bf16x8 At[4][2], B0[2][2], B1[2][2];
    const char* cA = PG8_UA(cur); const char* cB = (const char*)g.Bt + (size_t)cur.pn * tB;
    PG8_STAGE(PG8_SB(0, 0), cB, voffB); PG8_STAGE(PG8_SA(0, 0), cA, voffA); PG8_STAGE(PG8_SB(0, 1), cB + hB, voffB); PG8_STAGE(PG8_SA(0, 1), cA + hA, voffA);
    if (wr == 1) PG8_BAR;
    PG8_WAIT_V(4); PG8_BAR;
    PG8_STAGE(PG8_SB(1, 0), cB + kstep, voffB); PG8_STAGE(PG8_SA(1, 0), cA + kstep, voffA); PG8_STAGE(PG8_SB(1, 1), cB + hB + kstep, voffB);
    PG8_WAIT_V(6); PG8_BAR;
    for (;;) {
        const bool has_next = S.next(ui + 1, nxt);
        const char* nA = has_next ? PG8_UA(nxt) : cA; const char* nB = has_next ? (const char*)g.Bt + (size_t)nxt.pn * tB : cB;
        for (int t = 0; t < nt; t += 2) {
            const bool last = (t == nt - 2);
            const char* a1 = cA + (size_t)(t + 1) * kstep;
            const char* a2 = last ? nA : cA + (size_t)(t + 2) * kstep; const char* b2 = last ? nB : cB + (size_t)(t + 2) * kstep;
            const char* a3 = a2 + kstep; const char* b3 = b2 + kstep;
            PG8_LDB(B0, 0, 0); PG8_SCHED; PG8_LDA(At, 0, 0); PG8_STAGE(PG8_SA(1, 1), a1 + hA, voffA);
            PG8_WAIT_L(8); PG8_BAR; PG8_WAIT_L(0); PG8_MMA(0, 0, At, B0); PG8_BAR; PG8_SCHED;
            PG8_LDB(B1, 0, 1); PG8_STAGE(PG8_SB(0, 0), b2, voffB);
            PG8_BAR; PG8_WAIT_L(0); PG8_MMA(0, 1, At, B1); PG8_BAR;
            PG8_LDA(At, 0, 1); PG8_STAGE(PG8_SA(0, 0), a2, voffA);
            PG8_BAR; PG8_WAIT_L(0); PG8_MMA(1, 0, At, B0); PG8_BAR; PG8_SCHED;
            PG8_STAGE(PG8_SB(0, 1), b2 + hB, voffB);
            PG8_WAIT_V(6); PG8_BAR; PG8_MMA(1, 1, At, B1); PG8_BAR;
            PG8_LDB(B0, 1, 0); PG8_SCHED; PG8_LDA(At, 1, 0); PG8_STAGE(PG8_SA(0, 1), a2 + hA, voffA);
            PG8_WAIT_L(8); PG8_BAR; PG8_WAIT_L(0); PG8_MMA(0, 0, At, B0); PG8_BAR; PG8_SCHED;
            PG8_LDB(B1, 1, 1); PG8_STAGE(PG8_SB(1, 0), b3, voffB);
            PG8_BAR; PG8_WAIT_L(0); PG8_MMA(0, 1, At, B1); PG8_BAR;
            PG8_LDA(At, 1, 1); PG8_STAGE(PG8_SA(1, 0), a3, voffA);
            PG8_BAR; PG8_WAIT_L(0); PG8_MMA(1, 0, At, B0); PG8_BAR; PG8_SCHED;
            PG8_STAGE(PG8_SB(1, 1), b3 + hB, voffB);
            PG8_WAIT_V(6); PG8_BAR; PG8_MMA(1, 1, At, B1); PG8_BAR;
        }
        { int efr = fr, efq = fq; asm volatile("" : "+v"(efr), "+v"(efq)); E(acc, cur, wr, wc, efr, efq); }
        if (!has_next) break;
#pragma unroll
        for (int a = 0; a < 2; ++a)
#pragma unroll
            for (int b = 0; b < 2; ++b)
#pragma unroll
                for (int m = 0; m < 4; ++m)
#pragma unroll
                    for (int n = 0; n < 2; ++n) acc[a][b][m][n] = (f32x4){0.f, 0.f, 0.f, 0.f};
        cur = nxt; cA = nA; cB = nB; ++ui;
    }
    PG8_WAIT_V(0);
    if (wr == 0) PG8_BAR;
    PG8_BAR;
#undef PG8_SA
#undef PG8_SB
#undef PG8_STAGE
#undef PG8_LDA
#undef PG8_LDB
#undef PG8_MMA
#undef PG8_WAIT_V
#undef PG8_WAIT_L
#undef PG8_BAR
#undef PG8_SCHED
#undef PG8_UA
}
}
using pg8::Unit;
typedef f32x4 AccT[2][2][4][2];

struct EpiProj {
    static constexpr bool PERM = true;
    bf16_t* O; int col_off;
    __device__ __forceinline__ void operator()(const AccT& acc, const Unit& u, int wr, int wc, int fr, int fq) const {
        const int colt = u.pn * 256 + col_off;
        int act = 0;
        if (colt < 512) act = 1;
        const int row0 = u.pm * 256 + wr * 64 + fr, col0 = colt + wc * 32 + 8 * fq;
#pragma unroll
        for (int ai = 0; ai < 2; ++ai)
#pragma unroll
            for (int m = 0; m < 4; ++m) { bf16_t* rowp = O + (size_t)(row0 + ai * 128 + m * 16) * LDP + col0;
#pragma unroll
                for (int bj = 0; bj < 2; ++bj) { float v[8];
#pragma unroll
                    for (int j = 0; j < 4; ++j) { v[j] = acc[ai][bj][m][0][j]; v[4 + j] = acc[ai][bj][m][1][j]; }
#pragma unroll
                    for (int j = 0; j < 8; ++j) { float x = v[j];
                        if (act == 1) x *= 0.08838834764831845f;
                        v[j] = x; }
                    u32x4 w; w.x = pk2(v[0], v[1]); w.y = pk2(v[2], v[3]); w.z = pk2(v[4], v[5]); w.w = pk2(v[6], v[7]);
                    *(u32x4*)(rowp + bj * 128) = w; } }
    }
};
struct EpiLruGate {
    static constexpr bool PERM = false;
    const bf16_t* XC; unsigned* LAB; const float* cl; const float* ba; const float* bi;
    __device__ __forceinline__ void operator()(const AccT& acc, const Unit& u, int wr, int wc, int fr, int fq) const {
        const int e = u.pn / 12, nb = u.pn % 12;
        const int row0 = u.pm * 256 + wr * 64 + fr;
#pragma unroll
        for (int bj = 0; bj < 2; ++bj) {
            const int ch0 = nb * 128 + 16 * (4 * bj + wc) + 4 * fq;
            const f32x4 vcl = *(const f32x4*)(cl + e * 1536 + ch0), vba = *(const f32x4*)(ba + e * 1536 + ch0), vbi = *(const f32x4*)(bi + e * 1536 + ch0);
#pragma unroll
            for (int ai = 0; ai < 2; ++ai)
#pragma unroll
                for (int m = 0; m < 4; ++m) { const int row = row0 + ai * 128 + m * 16;
                    const u32x2 xw = *(const u32x2*)(XC + (size_t)row * 1536 + ch0);
                    const float xc[4] = {bflo(xw.x), bfhi(xw.x), bflo(xw.y), bfhi(xw.y)};
                    u32x4 w;
#pragma unroll
                    for (int j = 0; j < 4; ++j) { const float ga = acc[ai][bj][m][0][j] + vba[j], gi = acc[ai][bj][m][1][j] + vbi[j];
                        const float la = vcl[j] * sigm(ga);
                        const float bc = __builtin_amdgcn_sqrtf(fmaxf(-expm1_(2.f * la), 0.f)) * sigm(gi) * xc[j];
                        w[j] = pk2(la, bc); }
                    *(u32x4*)(LAB + ((size_t)row * 2 + e) * 1536 + ch0) = w; __builtin_amdgcn_sched_barrier(0); }
        }
    }
};
struct EpiGlu {
    static constexpr bool PERM = true;
    const bf16_t* YSA; bf16_t* YS5;
    __device__ __forceinline__ void operator()(const AccT& acc, const Unit& u, int wr, int wc, int fr, int fq) const {
        const int row0 = u.pm * 256 + wr * 64 + fr, col0 = u.pn * 256 + wc * 32 + 8 * fq;
#pragma unroll
        for (int ai = 0; ai < 2; ++ai)
#pragma unroll
            for (int m = 0; m < 4; ++m) { const size_t ro = (size_t)(row0 + ai * 128 + m * 16) * 1024 + col0;
#pragma unroll
                for (int bj = 0; bj < 2; ++bj) { const u32x4 a = *(const u32x4*)(YSA + ro + bj * 128);
                    const float y[8] = {bflo(a.x), bfhi(a.x), bflo(a.y), bfhi(a.y), bflo(a.z), bfhi(a.z), bflo(a.w), bfhi(a.w)};
                    float v[8];
#pragma unroll
                    for (int j = 0; j < 4; ++j) { v[j] = y[j] * sigm(acc[ai][bj][m][0][j]); v[4 + j] = y[4 + j] * sigm(acc[ai][bj][m][1][j]); }
                    u32x4 w; w.x = pk2(v[0], v[1]); w.y = pk2(v[2], v[3]); w.z = pk2(v[4], v[5]); w.w = pk2(v[6], v[7]);
                    *(u32x4*)(YS5 + ro + bj * 128) = w; } }
    }
};
struct EpiMerge {
    static constexpr bool PERM = true;
    int mode; const bf16_t* G; float* MRG; bf16_t* MERGED;
    __device__ __forceinline__ void operator()(const AccT& acc, const Unit& u, int wr, int wc, int fr, int fq) const {
        const int row0 = u.pm * 256 + wr * 64 + fr, col0 = u.pn * 256 + wc * 32 + 8 * fq;
#pragma unroll
        for (int ai = 0; ai < 2; ++ai)
#pragma unroll
            for (int m = 0; m < 4; ++m) { const int row = row0 + ai * 128 + m * 16;
#pragma unroll
                for (int bj = 0; bj < 2; ++bj) { const int col = col0 + bj * 128;
                    const u32x4 a = *(const u32x4*)(G + (size_t)row * LDP + col);
                    const float gg[8] = {sigm(bflo(a.x)), sigm(bfhi(a.x)), sigm(bflo(a.y)), sigm(bfhi(a.y)), sigm(bflo(a.z)), sigm(bfhi(a.z)), sigm(bflo(a.w)), sigm(bfhi(a.w))};
                    float* mp = MRG + (size_t)row * 1024 + col;
                    f32x4 v0, v1;
#pragma unroll
                    for (int j = 0; j < 4; ++j) { v0[j] = gg[j] * acc[ai][bj][m][0][j]; v1[j] = gg[4 + j] * acc[ai][bj][m][1][j]; }
                    if (mode != 0) { v0 += *(const f32x4*)mp; v1 += *(const f32x4*)(mp + 4); }
                    if (mode != 2) { *(f32x4*)mp = v0; *(f32x4*)(mp + 4) = v1; }
                    else { u32x4 w; w.x = pk2(v0[0], v0[1]); w.y = pk2(v0[2], v0[3]); w.z = pk2(v1[0], v1[1]); w.w = pk2(v1[2], v1[3]);
                        *(u32x4*)(MERGED + (size_t)row * 1024 + col) = w; } } }
    }
};
struct EpiRes {
    static constexpr bool PERM = false;
    const float* X; const float* gate; int seg; float* PRE; float xs;
    __device__ __forceinline__ void operator()(const AccT& acc, const Unit& u, int wr, int wc, int fr, int fq) const {
        const int row0 = u.pm * 256 + wr * 64 + fr, col0 = u.pn * 256 + wc * 32 + 4 * fq;
#pragma unroll
        for (int ai = 0; ai < 2; ++ai)
#pragma unroll
            for (int m = 0; m < 4; ++m) { const int row = row0 + ai * 128 + m * 16; const float* gp = gate + (size_t)modrow_of(seg, row) * 6144;
#pragma unroll
                for (int bj = 0; bj < 2; ++bj)
#pragma unroll
                    for (int n = 0; n < 2; ++n) { const int col = col0 + bj * 128 + n * 16;
                        const f32x4 xv = *(const f32x4*)(X + (size_t)row * 1024 + col), gv = *(const f32x4*)(gp + col);
                        *(f32x4*)(PRE + (size_t)row * 1024 + col) = xs * xv + gv * acc[ai][bj][m][n]; } }
    }
};
struct EpiRelu2 {
    static constexpr bool PERM = true;
    bf16_t* O;
    __device__ __forceinline__ void operator()(const AccT& acc, const Unit& u, int wr, int wc, int fr, int fq) const {
        const int row0 = u.pm * 256 + wr * 64 + fr, col0 = u.pn * 256 + wc * 32 + 8 * fq;
#pragma unroll
        for (int ai = 0; ai < 2; ++ai)
#pragma unroll
            for (int m = 0; m < 4; ++m) { bf16_t* rowp = O + (size_t)(row0 + ai * 128 + m * 16) * 4096 + col0;
#pragma unroll
                for (int bj = 0; bj < 2; ++bj) { float v[8];
#pragma unroll
                    for (int j = 0; j < 4; ++j) { float a = fmaxf(acc[ai][bj][m][0][j], 0.f), b = fmaxf(acc[ai][bj][m][1][j], 0.f); v[j] = a * a; v[4 + j] = b * b; }
                    u32x4 w; w.x = pk2(v[0], v[1]); w.y = pk2(v[2], v[3]); w.z = pk2(v[4], v[5]); w.w = pk2(v[6], v[7]);
                    *(u32x4*)(rowp + bj * 128) = w; } }
    }
};

template <class Epi>
__device__ __forceinline__ void run_gemm(unsigned char* lds, const bf16_t* A, int lda, const bf16_t* Bt, int ldb, int M, int N, int K, int ak_mod, int ak_bytes, const Epi& E) {
    pg8::Gemm g; g.A = A; g.Bt = Bt; g.M = M; g.N = N; g.K = K; g.lda = lda; g.ldb = ldb; g.ak_mod = ak_mod; g.ak_bytes = ak_bytes;
    pg8::StaticOrder S; S.init(M, N, (int)gridDim.x, (int)obid());
    pg8::gemm_phase<Epi>((LAS unsigned char*)lds, g, S, E);
}

template <class Epi>
__device__ __forceinline__ void run_gemm_sub(unsigned char* lds, const bf16_t* A, int lda, const bf16_t* Bt, int ldb, int M, int N, int K, int G, int c, const Epi& E) {
    pg8::Gemm g; g.A = A; g.Bt = Bt; g.M = M; g.N = N; g.K = K; g.lda = lda; g.ldb = ldb; g.ak_mod = 1; g.ak_bytes = 0;
    pg8::StaticOrder S; S.init(M, N, G, c);
    pg8::gemm_phase<Epi>((LAS unsigned char*)lds, g, S, E);
}
__device__ __forceinline__ void phase_mods(const Params& p, unsigned char* lds) {
    const int z = ozero();
    const int tid = otid();
    float* SC = (float*)lds;
    float* PS = (float*)(lds + 36864);
    const float* c = kin(6 + z); const float* cctx = kin(7 + z);
    for (int i = tid; i < 9 * 1024; i += 512) { const int r = i >> 10, k = i & 1023; const float v = r == 0 ? cctx[k] : c[(r - 1) * 1024 + k]; SC[i] = v * sigm(v); }
    __syncthreads();
    float* MOD = (float*)(((unsigned char*)kin(41 + z)) + WS_MOD);
    for (int it = obid(); it < 4 * 48; it += gridDim.x) {
        const int l = it / 48, cb = it % 48; const int col = cb * 128 + (tid & 127), kq = tid >> 7;
        const float* W = kin(8 + z) + (size_t)l * 1024 * 6144 + col;
        float a[9];
#pragma unroll
        for (int r = 0; r < 9; ++r) a[r] = 0.f;
        for (int k = kq * 256; k < kq * 256 + 256; ++k) { const float w = W[(size_t)k * 6144];
#pragma unroll
            for (int r = 0; r < 9; ++r) a[r] += SC[r * 1024 + k] * w; }
#pragma unroll
        for (int r = 0; r < 9; ++r) PS[(kq * 9 + r) * 128 + (tid & 127)] = a[r];
        __syncthreads();
        if (tid < 128) { const float b = kin(9 + z)[l * 6144 + col];
#pragma unroll
            for (int r = 0; r < 9; ++r) MOD[((size_t)l * 9 + r) * 6144 + col] = PS[(0 * 9 + r) * 128 + tid] + PS[(1 * 9 + r) * 128 + tid] + PS[(2 * 9 + r) * 128 + tid] + PS[(3 * 9 + r) * 128 + tid] + b; }
        __syncthreads();
    }
}
__device__ __forceinline__ void phase_xinit(const Params& p) {
    const int z = ozero();
    const size_t n4 = (size_t)40960 * 256; const size_t gs = (size_t)gridDim.x * 512;
    for (size_t i = (size_t)obid() * 512 + otid(); i < n4; i += gs) {
        const int tok = (int)(i >> 8), d0 = (int)(i & 255) * 4;
        f32x4 v;
        if (tok < 8192) v = *(const f32x4*)(kin(0 + z) + (size_t)tok * 1024 + d0);
        else { const int tl = tok - 8192; v = *(const f32x4*)(kin(1 + z) + (size_t)tl * 1024 + d0); const int t = tl & 4095;
#pragma unroll
            for (int j = 0; j < 4; ++j) { const int d = d0 + j, qt = d >> 8, i2 = d & 255;
                const float om = exp2f(-(float)i2 * (13.287712379549449f / 256.f));
                const float ps = (qt < 2) ? (float)(t >> 6) : (float)(t & 63);
                const float ag = ps * om;
                v[j] += (qt & 1) ? __cosf(ag) : __sinf(ag); } }
        *(f32x4*)(((float*)kin(40 + z)) + (size_t)tok * 1024 + d0) = v;
        {
            const float* MOD = (const float*)(((unsigned char*)kin(41 + z)) + WS_MOD); bf16_t* HA = (bf16_t*)(((unsigned char*)kin(41 + z)) + WS_HA);
            const int mr = tok < 8192 ? 0 : 1 + ((tok - 8192) >> 12);
            const f32x4 sh = *(const f32x4*)(MOD + (size_t)mr * 6144 + d0), sc = *(const f32x4*)(MOD + (size_t)mr * 6144 + 1024 + d0);
            u32x2 w; w.x = pk2(v[0] * (1.f + sc[0]) + sh[0], v[1] * (1.f + sc[1]) + sh[1]); w.y = pk2(v[2] * (1.f + sc[2]) + sh[2], v[3] * (1.f + sc[3]) + sh[3]);
            *(u32x2*)(HA + (size_t)tok * 1024 + d0) = w; }
    }
}
__device__ __forceinline__ void phase_ha0(const Params& p) {
    const int z = ozero();
    const float* MOD = (const float*)(((unsigned char*)kin(41 + z)) + WS_MOD); bf16_t* HA = (bf16_t*)(((unsigned char*)kin(41 + z)) + WS_HA);
    const size_t n4 = (size_t)40960 * 256; const size_t gs = (size_t)gridDim.x * 512;
    for (size_t i = (size_t)obid() * 512 + otid(); i < n4; i += gs) {
        const int tok = (int)(i >> 8), d0 = (int)(i & 255) * 4;
        const int mr = tok < 8192 ? 0 : 1 + ((tok - 8192) >> 12);
        const f32x4 x = *(const f32x4*)(((float*)kin(40 + z)) + (size_t)tok * 1024 + d0);
        const f32x4 sh = *(const f32x4*)(MOD + (size_t)mr * 6144 + d0), sc = *(const f32x4*)(MOD + (size_t)mr * 6144 + 1024 + d0);
        u32x2 w; w.x = pk2(x[0] * (1.f + sc[0]) + sh[0], x[1] * (1.f + sc[1]) + sh[1]); w.y = pk2(x[2] * (1.f + sc[2]) + sh[2], x[3] * (1.f + sc[3]) + sh[3]);
        *(u32x2*)(HA + (size_t)tok * 1024 + d0) = w;
    }
}
struct TrT { const float* src; bf16_t* dst; int ldn, k0, n0, ldd, dr, kofs, mode; };
__device__ __forceinline__ TrT tr_decode(int it, int l, int z, unsigned char* ws) {
    TrT t; t.kofs = 0; t.mode = 0;
    int i = it;
    if (i < 2568) { const int kt = i & 7, nt = i >> 3; const int n0 = nt * 32;
        t.src = kin(10 + z) + (size_t)l * 1024 * 10272; t.ldn = 10272; t.k0 = kt * 128; t.n0 = n0; t.dst = (bf16_t*)(ws + WS_WIN); t.ldd = 1024;
        t.dr = n0 < 3072 ? n0 : (n0 < 3104 ? 10240 + (n0 - 3072) : n0 - 32); return t; }
    i -= 2568;
    if (i < 256) { t.src = kin(22 + z) + (size_t)l * 1048576; t.ldn = 1024; t.k0 = (i & 7) * 128; t.n0 = (i >> 3) * 32; t.dst = (bf16_t*)(ws + WS_WGLU); t.ldd = 1024; t.dr = (i >> 3) * 32; return t; }
    i -= 256;
    if (i < 256) { t.src = kin(30 + z) + (size_t)l * 1048576; t.ldn = 1024; t.k0 = (i & 7) * 128; t.n0 = (i >> 3) * 32; t.dst = (bf16_t*)(ws + WS_WBG); t.ldd = 1024; t.dr = (i >> 3) * 32; return t; }
    i -= 256;
    if (i < 256) { t.src = kin(31 + z) + (size_t)l * 1048576; t.ldn = 1024; t.k0 = (i & 7) * 128; t.n0 = (i >> 3) * 32; t.dst = (bf16_t*)(ws + WS_WBS); t.ldd = 1024; t.dr = (i >> 3) * 32; return t; }
    i -= 256;
    if (i < 384) { const int kt = i % 12, nt = i / 12; t.src = kin(32 + z) + (size_t)l * 1536 * 1024; t.ldn = 1024; t.k0 = kt * 128; t.n0 = nt * 32; t.dst = (bf16_t*)(ws + WS_WBL); t.ldd = 1536; t.dr = nt * 32; return t; }
    i -= 384;
    if (i < 256) { t.src = kin(33 + z) + (size_t)l * 1048576; t.ldn = 1024; t.k0 = (i & 7) * 128; t.n0 = (i >> 3) * 32; t.dst = (bf16_t*)(ws + WS_WOUT); t.ldd = 1024; t.dr = (i >> 3) * 32; return t; }
    i -= 256;
    if (i < 1024) { t.src = kin(38 + z) + (size_t)l * 4194304; t.ldn = 4096; t.k0 = (i & 7) * 128; t.n0 = (i >> 3) * 32; t.dst = (bf16_t*)(ws + WS_WMI); t.ldd = 1024; t.dr = (i >> 3) * 32; return t; }
    i -= 1024;
    if (i < 1024) { t.src = kin(39 + z) + (size_t)l * 4194304; t.ldn = 1024; t.k0 = (i & 31) * 128; t.n0 = (i >> 5) * 32; t.dst = (bf16_t*)(ws + WS_WMO); t.ldd = 4096; t.dr = (i >> 5) * 32; return t; }
    i -= 1024;
    { const int dt = i & 3; int r = i >> 2; const int nb = r % 12; r /= 12; const int e = r & 1, ai = r >> 1;
        t.src = (ai ? kin(27 + z) : kin(25 + z)) + ((size_t)(l * 2 + e) * 12 + nb) * 16384; t.ldn = 128; t.k0 = 0; t.n0 = dt * 32; t.dst = (bf16_t*)(ws + WS_WLRU); t.ldd = 256;
        t.dr = (e * 12 + nb) * 256 + (dt * 2) * 32 + ai * 16; t.kofs = (nb & 1) * 128; t.mode = 1; }
    return t;
}
__device__ __forceinline__ void tr_load(const TrT& t, float (&v)[8], int tid) {
#pragma unroll
    for (int i = 0; i < 8; ++i) { const int kk = (tid >> 5) + 16 * i, nn = tid & 31; v[i] = __builtin_nontemporal_load(t.src + (size_t)(t.k0 + kk) * t.ldn + t.n0 + nn); }
}
__device__ __forceinline__ void tr_store(unsigned char* lds, const TrT& t, const float (&v)[8], int tid) {
    float* tile = (float*)lds;
#pragma unroll
    for (int i = 0; i < 8; ++i) { const int kk = (tid >> 5) + 16 * i, nn = tid & 31; tile[kk * 33 + nn] = v[i]; }
    __syncthreads();
    const int nn = tid >> 4, kq = tid & 15;
    u32x4 w;
#pragma unroll
    for (int j = 0; j < 4; ++j) w[j] = pk2(tile[(kq * 8 + 2 * j) * 33 + nn], tile[(kq * 8 + 2 * j + 1) * 33 + nn]);
    const int row = t.mode ? t.dr + (nn >> 4) * 32 + (nn & 15) : t.dr + nn;
    *(u32x4*)(t.dst + (size_t)row * t.ldd + t.kofs + t.k0 + kq * 8) = w;
    if (t.mode) *(u32x4*)(t.dst + (size_t)row * t.ldd + (128 - t.kofs) + kq * 8) = (u32x4){0u, 0u, 0u, 0u};
    __syncthreads();
}
__device__ __forceinline__ void phase_layer_setup(const Params& p, int l, unsigned char* lds) {
    const int z = ozero();
    unsigned char* ws = (unsigned char*)kin(41 + z);
    { const int tid = otid(), G = (int)gridDim.x; int it = obid();
        if (it < 6216) { TrT cur = tr_decode(it, l, z, ws); float v[8]; tr_load(cur, v, tid);
            for (;;) { const int nx = it + G; const bool hn = nx < 6216; TrT nxt = cur; float w[8];
                if (hn) { nxt = tr_decode(nx, l, z, ws); tr_load(nxt, w, tid); }
                tr_store(lds, cur, v, tid);
                if (!hn) break;
                cur = nxt; it = nx;
#pragma unroll
                for (int q = 0; q < 8; ++q) v[q] = w[q]; } } }
    const int gt = obid() * 512 + otid(), gs = gridDim.x * 512;
    for (int i = gt; i < 224 * 128; i += gs) *(u32x4*)((bf16_t*)(ws + WS_WIN) + (size_t)10272 * 1024 + (size_t)i * 8) = (u32x4){0u, 0u, 0u, 0u};
    for (int i = gt; i < 2 * 64 * 64; i += gs) { const int pp = i & 63, G = (i >> 6) & 63, e = i >> 12;
        const float step = __expf(kin(16 + z)[(l * 2 + e) * 64 + G]);
        const float lr = kin(14 + z)[((size_t)(l * 2 + e) * 64 + G) * 64 + pp], li = kin(15 + z)[((size_t)(l * 2 + e) * 64 + G) * 64 + pp];
        const float mag = __expf(lr * step), ang = li * step;
        const float are = mag * __cosf(ang), aim = mag * __sinf(ang);
        const float den = lr * lr + li * li, nr = are - 1.f;
        const float fre = (nr * lr + aim * li) / den, fim = (aim * lr - nr * li) / den;
        ((float2*)(ws + WS_S5AB))[i] = make_float2(are, aim);
        const float* bre = kin(17 + z) + ((size_t)(l * 64 + G) * 64 + pp) * 16; const float* bim = kin(18 + z) + ((size_t)(l * 64 + G) * 64 + pp) * 16;
        bf16_t* o = (bf16_t*)(ws + WS_S5B) + ((size_t)(e * 64 + G) * 128) * 16;
#pragma unroll
        for (int j = 0; j < 16; ++j) { const float br = bre[j], bi = bim[j]; o[pp * 16 + j] = f2bf(fre * br - fim * bi); o[(64 + pp) * 16 + j] = f2bf(fre * bi + fim * br); } }
    for (int i = gt; i < 64 * 16 * 64; i += gs) { const int pp = i & 63, ii = (i >> 6) & 15, G = i >> 10;
        bf16_t* o = (bf16_t*)(ws + WS_S5C) + ((size_t)G * 16 + ii) * 128;
        o[pp] = f2bf(kin(19 + z)[((size_t)(l * 64 + G) * 16 + ii) * 64 + pp]); o[64 + pp] = f2bf(-kin(20 + z)[((size_t)(l * 64 + G) * 16 + ii) * 64 + pp]); }
    for (int i = gt; i < 2 * 1536; i += gs) { const float lam = kin(29 + z)[(size_t)l * 3072 + i]; ((float*)(ws + WS_LCL))[i] = -8.f * (fmaxf(-lam, 0.f) + log1p_(__expf(-fabsf(lam)))); }
}

__device__ __forceinline__ void phase_conv(const Params& p, int l, int seg) {
    const int z = ozero();
    const bf16_t* PROJ = (const bf16_t*)(((unsigned char*)kin(41 + z)) + WS_PROJ); bf16_t* XC = (bf16_t*)(((unsigned char*)kin(41 + z)) + WS_XC);
    const int T = seg == 0 ? 256 : 4096;
    const float* cw = kin(23 + z) + (size_t)l * 4 * 1536; const float* cb = kin(24 + z) + (size_t)l * 1536;
    const int bid = obid(); int nb = (int)gridDim.x, eb = bid;
    if (seg != 0) { if ((bid & 7) == 7) return; nb -= nb >> 3; eb = bid - (bid >> 3); }
    const int n = SEG * 192, gs = nb * 512;
    for (int i = eb * 512 + otid(); i < n; i += gs) {
        const int row = i / 192, ch = (i % 192) * 8; const int t = row & (T - 1);
        float a[8];
#pragma unroll
        for (int j = 0; j < 8; ++j) a[j] = cb[ch + j];
#pragma unroll
        for (int tap = 0; tap < 4; ++tap) { const int tt = t + tap - 2;
            if (tt >= 0 && tt < T) { const u32x4 v = *(const u32x4*)(PROJ + (size_t)(row + tap - 2) * LDP + CLX + ch);
                const float x[8] = {bflo(v.x), bfhi(v.x), bflo(v.y), bfhi(v.y), bflo(v.z), bfhi(v.z), bflo(v.w), bfhi(v.w)};
#pragma unroll
                for (int j = 0; j < 8; ++j) a[j] += cw[tap * 1536 + ch + j] * x[j]; } }
        u32x4 w; w.x = pk2(a[0], a[1]); w.y = pk2(a[2], a[3]); w.z = pk2(a[4], a[5]); w.w = pk2(a[6], a[7]);
        *(u32x4*)(XC + (size_t)row * 1536 + ch) = w;
    }
}

__device__ __forceinline__ void unpack8(const u32x4 a, float* y) { y[0] = bflo(a.x); y[1] = bfhi(a.x); y[2] = bflo(a.y); y[3] = bfhi(a.y); y[4] = bflo(a.z); y[5] = bfhi(a.z); y[6] = bflo(a.w); y[7] = bfhi(a.w); }
__device__ __forceinline__ u32x4 pack8(const float* v) { u32x4 w; w.x = pk2(v[0], v[1]); w.y = pk2(v[2], v[3]); w.z = pk2(v[4], v[5]); w.w = pk2(v[6], v[7]); return w; }
#define MFMA16(a, b, c) __builtin_amdgcn_mfma_f32_16x16x32_bf16(a, b, c, 0, 0, 0)

__device__ __forceinline__ void gla_items(const Params& p, int l, int seg, int pass, unsigned char* lds) {
    const int z = ozero();
    const int tid = otid(), lane = tid & 63, w = tid >> 6, quad = lane >> 4, l15 = lane & 15;
    const bool ctx = (seg == 0);
    const int T = ctx ? 256 : 4096, nseq = ctx ? 32 : 2, nsc = ctx ? 1 : 8, nch = ctx ? 4 : 8;
    if (pass == 1 && nsc == 1) return;
    const int nitems = nseq * 16 * nsc;
    unsigned char* ws = (unsigned char*)kin(41 + z);
    bf16_t* QD = (bf16_t*)(lds); bf16_t* KI = (bf16_t*)(lds + 17408); bf16_t* KET = (bf16_t*)(lds + 34816); bf16_t* VT = (bf16_t*)(lds + 53248);
    bf16_t* ST = (bf16_t*)(lds + 71680); float* CUM = (float*)(lds + 71680); bf16_t* Pm = (bf16_t*)(lds + 106496);
    bf16_t* GLRb = (bf16_t*)(lds + 115712);   float* DL = (float*)(lds + 121856); float* LAST = (float*)(lds + 122368);
    const bf16_t* PROJ = (const bf16_t*)(ws + WS_PROJ);
    float* GST = (float*)(ws + WS_GST); float* GLT = (float*)(ws + WS_GLT);
    const int k = tid & 127, part = tid >> 7;
    for (int it = obid(); it < nitems; it += gridDim.x) {
        const int sc = it % nsc; int r = it / nsc; const int vh = r & 1, dir = (r >> 1) & 1, h = (r >> 2) & 3, sq = r >> 4;
        if (pass == 1 && sc == nsc - 1) continue;
        bf16x8 wgb = (bf16x8){0, 0, 0, 0, 0, 0, 0, 0};
        if (quad < 2) { float wv8[8];
#pragma unroll
            for (int j = 0; j < 8; ++j) wv8[j] = kin(11 + z)[((size_t)(l * 2 + dir) * 16 + quad * 8 + j) * 512 + h * 128 + w * 16 + l15];
            const u32x4 pw = pack8(wv8); wgb = __builtin_bit_cast(bf16x8, pw); }
        const float bgk = kin(12 + z)[(size_t)(l * 2 + dir) * 512 + h * 128 + w * 16 + l15];
        f32x4 accs[8];
        float ltot = 0.f;
        if (pass == 2 && !ctx) {
            const int b = (seg - 1) * 2 + sq;
            const float* s0 = kin(2 + z) + ((((size_t)b * 4 + l) * 2 + dir) * 4 + h) * 32768 + vh * 128;
#pragma unroll
            for (int vt = 0; vt < 8; ++vt)
#pragma unroll
                for (int j = 0; j < 4; ++j) accs[vt][j] = s0[(size_t)(w * 16 + quad * 4 + j) * 256 + vt * 16 + l15];
            for (int j2 = 0; j2 < sc; ++j2) { const int itj = it - sc + j2; const float* sl = GST + (size_t)itj * 16384; const float* lt = GLT + (size_t)itj * 128;
                const f32x4 l4 = *(const f32x4*)(lt + w * 16 + quad * 4);
                const f32x4 dk = (f32x4){__expf(l4[0]), __expf(l4[1]), __expf(l4[2]), __expf(l4[3])};
#pragma unroll
                for (int vt = 0; vt < 8; ++vt) accs[vt] = dk * accs[vt] + *(const f32x4*)(sl + (vt * 16 + l15) * 128 + w * 16 + quad * 4); }
        } else {
#pragma unroll
            for (int vt = 0; vt < 8; ++vt) accs[vt] = (f32x4){0.f, 0.f, 0.f, 0.f};
        }
        bf16_t* Og = (bf16_t*)(ws + (dir ? WS_OB : WS_OF));
        const int rsgn = dir ? -1 : 1;
        const int rb0 = sq * T + (dir ? (T - 1 - sc * nch * 64) : sc * nch * 64);
#pragma unroll
        for (int i = 0; i < 2; ++i) { const int idx = tid + 512 * i; GLRb[(idx >> 4) * 24 + (idx & 15)] = PROJ[(size_t)(rb0 + rsgn * (idx >> 4)) * LDP + CGLR + dir * 16 + (idx & 15)]; }
        __syncthreads();
        for (int c = 0; c < nch; ++c) {
            const int rbase = rb0 + rsgn * c * 64;
            u32x4 q8r[2], k8r[2]; bf16_t kraw[2][8], vraw[2][8];
            if (pass == 2) {
#pragma unroll
                for (int i = 0; i < 2; ++i) { const int e = tid + 512 * i; const int tau = e >> 4, ko = (e & 15) * 8;
                    const bf16_t* rp = PROJ + (size_t)(rbase + rsgn * tau) * LDP + h * 128 + ko;
                    q8r[i] = *(const u32x4*)(rp + CQ); k8r[i] = *(const u32x4*)(rp + CK); }
            }
#pragma unroll
            for (int i = 0; i < 2; ++i) { const int e = tid + 512 * i; const int kk = e & 127, t0 = (e >> 7) * 8;
                const bf16_t* rp = PROJ + (size_t)(rbase + rsgn * t0) * LDP + h * 128 + kk;
#pragma unroll
                for (int j = 0; j < 8; ++j) { const bf16_t* rj = rp + (long)(rsgn * j) * LDP; kraw[i][j] = rj[CK]; vraw[i][j] = rj[CV + h * 128 + vh * 128]; } }
            { float base = 0.f;
#pragma unroll
                for (int tt = 0; tt < 4; ++tt) {
                    const bf16x8 a = quad < 2 ? *(const bf16x8*)&GLRb[(tt * 16 + l15) * 24 + quad * 8] : (bf16x8){0, 0, 0, 0, 0, 0, 0, 0};
                    const f32x4 lg4 = MFMA16(a, wgb, ((f32x4){0.f, 0.f, 0.f, 0.f}));
                    float c[4]; float run = 0.f;
#pragma unroll
                    for (int j = 0; j < 4; ++j) { run += logsig_(lg4[j] + bgk) * 0.0625f; c[j] = run; }
                    float v = run;
                    { const float t1 = __shfl_up(v, 16); if (quad >= 1) v += t1; const float t2 = __shfl_up(v, 32); if (quad >= 2) v += t2; }
                    const float tile_tot = __shfl(v, 48 + l15);
                    const float off = base + (v - run);
#pragma unroll
                    for (int j = 0; j < 4; ++j) CUM[(tt * 16 + quad * 4 + j) * 128 + w * 16 + l15] = c[j] + off;
                    base += tile_tot; }
                if (quad == 0) { LAST[w * 16 + l15] = base; DL[w * 16 + l15] = __expf(base); ltot += base; } }
            __syncthreads();
            if (pass == 2) {
#pragma unroll
                for (int i = 0; i < 2; ++i) { const int e = tid + 512 * i; const int tau = e >> 4, ko = (e & 15) * 8;
                    const u32x4 q8 = q8r[i], k8 = k8r[i];
                    const f32x4 c0 = *(const f32x4*)&CUM[tau * 128 + ko], c1 = *(const f32x4*)&CUM[tau * 128 + ko + 4];
                    float fq[8], fk[8], vq[8], vk[8]; unpack8(q8, fq); unpack8(k8, fk);
#pragma unroll
                    for (int j = 0; j < 8; ++j) { const float ec = __expf(j < 4 ? c0[j] : c1[j - 4]); vq[j] = fq[j] * ec; vk[j] = fk[j] * __builtin_amdgcn_rcpf(ec); }
                    *(u32x4*)&QD[tau * 136 + ko] = pack8(vq); *(u32x4*)&KI[tau * 136 + ko] = pack8(vk); }
            }
#pragma unroll
            for (int i = 0; i < 2; ++i) { const int e = tid + 512 * i; const int kk = e & 127, t0 = (e >> 7) * 8;
                const float lastv = LAST[kk];
                float vk[8]; bf16_t vv[8];
#pragma unroll
                for (int j = 0; j < 8; ++j) { vk[j] = bf2f(kraw[i][j]) * __expf(lastv - CUM[(t0 + j) * 128 + kk]); vv[j] = vraw[i][j]; }
                *(u32x4*)&KET[kk * 72 + t0] = pack8(vk);
                u32x4 wv; wv.x = (unsigned)vv[0] | ((unsigned)vv[1] << 16); wv.y = (unsigned)vv[2] | ((unsigned)vv[3] << 16); wv.z = (unsigned)vv[4] | ((unsigned)vv[5] << 16); wv.w = (unsigned)vv[6] | ((unsigned)vv[7] << 16);
                *(u32x4*)&VT[kk * 72 + t0] = wv; }
            if (c + 1 < nch) {
#pragma unroll
                for (int i = 0; i < 2; ++i) { const int idx = tid + 512 * i; GLRb[(idx >> 4) * 24 + (idx & 15)] = PROJ[(size_t)(rbase + rsgn * (64 + (idx >> 4))) * LDP + CGLR + dir * 16 + (idx & 15)]; } }
            __syncthreads();
            if (pass == 2) {
                { const int tt = w >> 1, st0 = (w & 1) * 2;
#pragma unroll
                    for (int s2 = 0; s2 < 2; ++s2) { const int st = st0 + s2; f32x4 a4 = (f32x4){0.f, 0.f, 0.f, 0.f};
                        if (st <= tt)
#pragma unroll
                        for (int ks = 0; ks < 4; ++ks) { const bf16x8 a = *(const bf16x8*)&QD[(tt * 16 + l15) * 136 + ks * 32 + quad * 8]; const bf16x8 b = *(const bf16x8*)&KI[(st * 16 + l15) * 136 + ks * 32 + quad * 8]; a4 = MFMA16(a, b, a4); }
#pragma unroll
                        for (int j = 0; j < 4; ++j) { const int t = tt * 16 + quad * 4 + j, s = st * 16 + l15; Pm[t * 72 + s] = f2bf(s <= t ? a4[j] : 0.f); } } }
#pragma unroll
                for (int vt = 0; vt < 8; ++vt) { u32x2 sv; sv.x = pk2(accs[vt][0], accs[vt][1]); sv.y = pk2(accs[vt][2], accs[vt][3]); *(u32x2*)&ST[(vt * 16 + l15) * 136 + w * 16 + quad * 4] = sv; }
                __syncthreads();
#pragma unroll
                for (int tt = 0; tt < 4; ++tt) { f32x4 o = (f32x4){0.f, 0.f, 0.f, 0.f};
#pragma unroll
                    for (int ks = 0; ks < 2; ++ks) { if (ks == 1 && tt < 2) continue;
                        const bf16x8 a = *(const bf16x8*)&Pm[(tt * 16 + l15) * 72 + ks * 32 + quad * 8]; const bf16x8 b = *(const bf16x8*)&VT[(w * 16 + l15) * 72 + ks * 32 + quad * 8]; o = MFMA16(a, b, o); }
#pragma unroll
                    for (int ks = 0; ks < 4; ++ks) { const bf16x8 a = *(const bf16x8*)&QD[(tt * 16 + l15) * 136 + ks * 32 + quad * 8]; const bf16x8 b = *(const bf16x8*)&ST[(w * 16 + l15) * 136 + ks * 32 + quad * 8]; o = MFMA16(a, b, o); }
#pragma unroll
                    for (int j = 0; j < 4; ++j) { const int tau = tt * 16 + quad * 4 + j; Og[(size_t)(rbase + rsgn * tau) * 1024 + h * 256 + vh * 128 + w * 16 + l15] = f2bf(o[j]); } }
            }
            { const f32x4 dl4 = *(const f32x4*)&DL[w * 16 + quad * 4];
                bf16x8 ak[2];
#pragma unroll
                for (int ks = 0; ks < 2; ++ks) ak[ks] = *(const bf16x8*)&KET[(w * 16 + l15) * 72 + ks * 32 + quad * 8];
#pragma unroll
                for (int vt = 0; vt < 8; ++vt) { accs[vt] *= dl4;
#pragma unroll
                    for (int ks = 0; ks < 2; ++ks) { const bf16x8 b = *(const bf16x8*)&VT[(vt * 16 + l15) * 72 + ks * 32 + quad * 8]; accs[vt] = MFMA16(ak[ks], b, accs[vt]); } } }
            __syncthreads();
        }
        if (pass == 1) {
            float* sl = GST + (size_t)it * 16384;
#pragma unroll
            for (int vt = 0; vt < 8; ++vt) *(f32x4*)(sl + (vt * 16 + l15) * 128 + w * 16 + quad * 4) = accs[vt];
            if (quad == 0) GLT[(size_t)it * 128 + w * 16 + l15] = ltot;
        } else if (ctx) {
            float* so = ((float*)kin(40 + z)) + OUT_GLA + ((((size_t)sq * 4 + l) * 2 + dir) * 4 + h) * 32768 + vh * 128;
#pragma unroll
            for (int vt = 0; vt < 8; ++vt)
#pragma unroll
                for (int j = 0; j < 4; ++j) so[(size_t)(w * 16 + quad * 4 + j) * 256 + vt * 16 + l15] = accs[vt][j];
        }
    }
}

#define WSYNC() asm volatile("s_waitcnt lgkmcnt(0)" ::: "memory")
__device__ __forceinline__ void s5_items(const Params& p, int l, int seg, int pass, unsigned char* lds) {
    const int z = ozero();
    const int tid = otid(), lane = tid & 63, w = tid >> 6, quad = lane >> 4, l15 = lane & 15;
    const bool ctx = (seg == 0);
    const int T = ctx ? 256 : 4096, nseq = ctx ? 32 : 2, nsc = ctx ? 1 : 8;
    if (pass == 1 && nsc == 1) return;
    const int Lsc = T / nsc, nsub = Lsc / 16;
    const int nitems = nseq * 16 * nsc;
    unsigned char* wl = lds + w * 13824;
    bf16_t* UL = (bf16_t*)wl;
    float* X = (float*)(wl + 768);
    bf16_t* H = (bf16_t*)(wl + 768 + 8448);
    const bf16_t* PROJ = (const bf16_t*)(((unsigned char*)kin(41 + z)) + WS_PROJ);
    const float2* AB = (const float2*)(((unsigned char*)kin(41 + z)) + WS_S5AB); const bf16_t* SB = (const bf16_t*)(((unsigned char*)kin(41 + z)) + WS_S5B); const bf16_t* SCm = (const bf16_t*)(((unsigned char*)kin(41 + z)) + WS_S5C);
    float2* E = (float2*)(((unsigned char*)kin(41 + z)) + WS_S5E);
    for (int it = obid(); it < nitems; it += gridDim.x) {
        const int sc = it % nsc; int r = it / nsc; const int oct = r & 7, dir = (r >> 3) & 1, sq = r >> 4;
        if (pass == 1 && sc == nsc - 1) continue;
        const int G = oct * 8 + w, pp = lane;
        const float2 ab = AB[(dir * 64 + G) * 64 + pp];
        bf16x8 bx[8], by[4];
        const bf16x8 zero8 = (bf16x8){0, 0, 0, 0, 0, 0, 0, 0};
#pragma unroll
        for (int ct = 0; ct < 8; ++ct) bx[ct] = quad < 2 ? *(const bf16x8*)(SB + ((size_t)(dir * 64 + G) * 128 + ct * 16 + l15) * 16 + quad * 8) : zero8;
#pragma unroll
        for (int ks = 0; ks < 4; ++ks) by[ks] = *(const bf16x8*)(SCm + ((size_t)G * 16 + l15) * 128 + ks * 32 + quad * 8);
        float hre = 0.f, him = 0.f;
        if (pass == 2 && !ctx) {
            const int b = (seg - 1) * 2 + sq;
            hre = kin(3 + z)[((((size_t)b * 4 + l) * 2 + dir) * 64 + G) * 64 + pp]; him = kin(4 + z)[((((size_t)b * 4 + l) * 2 + dir) * 64 + G) * 64 + pp];
            if (sc > 0) { float pr = ab.x, pi = ab.y;
                for (int s = 0; s < 9; ++s) { const float nr = pr * pr - pi * pi, ni = 2.f * pr * pi; pr = nr; pi = ni; }
                for (int j2 = 0; j2 < sc; ++j2) { const float2 e = E[(size_t)(it - sc + j2) * 512 + tid]; const float nr = pr * hre - pi * him + e.x, ni = pr * him + pi * hre + e.y; hre = nr; him = ni; } }
        }
        bf16_t* Yg = (bf16_t*)(((unsigned char*)kin(41 + z)) + (dir ? WS_YSB : WS_YSF));
        const int rsgn = dir ? -1 : 1;
        const int rb0 = sq * T + (dir ? (T - 1 - sc * Lsc) : sc * Lsc);
        const int ut = lane >> 2, uc = (lane & 3) * 4;
        const bf16_t* up = PROJ + (size_t)(rb0 + rsgn * ut) * LDP + CU + G * 16 + uc;
        const long ustep = (long)rsgn * 16 * LDP;
        u32x2 ucur = *(const u32x2*)up;
        for (int sb = 0; sb < nsub; ++sb) {
            const int rbase = rb0 + rsgn * sb * 16;
            *(u32x2*)&UL[ut * 24 + uc] = ucur;
            if (sb + 1 < nsub) ucur = *(const u32x2*)(up + (long)(sb + 1) * ustep);
            WSYNC();
            { const bf16x8 a = quad < 2 ? *(const bf16x8*)&UL[l15 * 24 + quad * 8] : zero8;
#pragma unroll
                for (int ct = 0; ct < 8; ++ct) { f32x4 x4 = MFMA16(a, bx[ct], ((f32x4){0.f, 0.f, 0.f, 0.f}));
#pragma unroll
                    for (int j = 0; j < 4; ++j) X[(quad * 4 + j) * 132 + ct * 16 + l15] = x4[j]; } }
            WSYNC();
#pragma unroll
            for (int t = 0; t < 16; ++t) { const float xr = X[t * 132 + pp], xi = X[t * 132 + 64 + pp];
                const float nr = ab.x * hre - ab.y * him + xr, ni = ab.x * him + ab.y * hre + xi; hre = nr; him = ni;
                if (pass == 2) { H[t * 136 + pp] = f2bf(hre); H[t * 136 + 64 + pp] = f2bf(him); } }
            WSYNC();
            if (pass == 2) { f32x4 y4 = (f32x4){0.f, 0.f, 0.f, 0.f};
#pragma unroll
                for (int ks = 0; ks < 4; ++ks) { const bf16x8 a = *(const bf16x8*)&H[l15 * 136 + ks * 32 + quad * 8]; y4 = MFMA16(a, by[ks], y4); }
#pragma unroll
                for (int j = 0; j < 4; ++j) Yg[(size_t)(rbase + rsgn * (quad * 4 + j)) * 1024 + G * 16 + l15] = f2bf(y4[j]); }
            WSYNC();
        }
        if (pass == 1) E[(size_t)it * 512 + tid] = make_float2(hre, him);
        else if (ctx) { const size_t o = ((((size_t)sq * 4 + l) * 2 + dir) * 64 + G) * 64 + pp; ((float*)kin(40 + z))[OUT_S5RE + o] = hre; ((float*)kin(40 + z))[OUT_S5IM + o] = him; }
    }
    __syncthreads();
}

__device__ __forceinline__ void lru_scan(const Params& p, int l, int seg, int pass) {
    const int z = ozero();
    const bool ctx = (seg == 0);
    const int T = ctx ? 256 : 4096, nseq = ctx ? 32 : 2, nsc = ctx ? 1 : 16;
    if (pass == 1 && nsc == 1) return;
    const int n = nseq * 2 * nsc * 1536;
    const unsigned* LAB = (const unsigned*)(((unsigned char*)kin(41 + z)) + WS_LAB); float2* LRC = (float2*)(((unsigned char*)kin(41 + z)) + WS_LRC);
    const int per = (n + (int)gridDim.x - 1) / (int)gridDim.x;
    const int lt = otid();
    for (int idx = obid() * per + lt; lt < per && idx < n; idx += n) {
        const int ch = idx % 1536; int r = idx / 1536; const int sc = r % nsc; r /= nsc; const int dir = r & 1, sq = r >> 1;
        if (pass == 1 && sc == nsc - 1) continue;
        const int pos0 = sc * 256;
        const int rbase = sq * T + (dir ? (T - 1 - pos0) : pos0); const int rsgn = dir ? -1 : 1;
        const unsigned* lp = LAB + ((size_t)rbase * 2 + dir) * 1536 + ch; const long lstep = (long)rsgn * 3072;
        float h = 0.f;
        if (pass == 1) { float sl = 0.f;
            for (int t0 = 0; t0 < 256; t0 += 16) { unsigned wv[16];
#pragma unroll
                for (int i = 0; i < 16; ++i) wv[i] = lp[(long)(t0 + i) * lstep];
#pragma unroll
                for (int i = 0; i < 16; ++i) { const float la = bflo(wv[i]), b = bfhi(wv[i]); sl += la; h = __expf(la) * h + b; } }
            LRC[idx] = make_float2(sl, h);
        } else {
            if (!ctx) { const int b = (seg - 1) * 2 + sq; h = kin(5 + z)[(((size_t)b * 4 + l) * 2 + dir) * 1536 + ch];
                for (int j = 0; j < sc; ++j) { const float2 e = LRC[idx - (sc - j) * 1536]; h = __expf(e.x) * h + e.y; } }
            bf16_t* Hg = (bf16_t*)(((unsigned char*)kin(41 + z)) + (dir ? WS_HB : WS_HF)) + (size_t)rbase * 1536 + ch; const long hstep = (long)rsgn * 1536;
            for (int t0 = 0; t0 < 256; t0 += 16) { unsigned wv[16];
#pragma unroll
                for (int i = 0; i < 16; ++i) wv[i] = lp[(long)(t0 + i) * lstep];
#pragma unroll
                for (int i = 0; i < 16; ++i) { const float la = bflo(wv[i]), b = bfhi(wv[i]); h = __expf(la) * h + b; Hg[(long)(t0 + i) * hstep] = f2bf(h); } }
            if (ctx) ((float*)kin(40 + z))[OUT_LRU + (((size_t)sq * 4 + l) * 2 + dir) * 1536 + ch] = h;
        }
    }
}

__device__ __forceinline__ void phase_post(const Params& p, int l) {
    const int z = ozero();
    unsigned char* ws = (unsigned char*)kin(41 + z);
    const int tid = otid(), gt = obid() * 512 + tid, gs = gridDim.x * 512;
    const bf16_t* PROJ = (const bf16_t*)(ws + WS_PROJ);
    {
        const bf16_t* OF = (const bf16_t*)(ws + WS_OF); const bf16_t* OB = (const bf16_t*)(ws + WS_OB); bf16_t* YG = (bf16_t*)(ws + WS_YG);
        const float* ng = kin(13 + z) + (size_t)l * 1024;
        const int sub = tid & 31, ngrp = gs >> 5;
#pragma unroll 2
        for (int g = gt >> 5; g < SEG * 4; g += ngrp) { const int row = g >> 2, c = (g & 3) * 256 + sub * 8;
            const u32x4 oa = *(const u32x4*)(OF + (size_t)row * 1024 + c), ob = *(const u32x4*)(OB + (size_t)row * 1024 + c);
            float fa8[8], fb8[8]; unpack8(oa, fa8); unpack8(ob, fb8);
            const f32x4 a0 = (f32x4){fa8[0], fa8[1], fa8[2], fa8[3]}, a1 = (f32x4){fa8[4], fa8[5], fa8[6], fa8[7]};
            const f32x4 b0 = (f32x4){fb8[0], fb8[1], fb8[2], fb8[3]}, b1 = (f32x4){fb8[4], fb8[5], fb8[6], fb8[7]};
            const u32x4 rw = *(const u32x4*)(PROJ + (size_t)row * LDP + CR + c);
            const f32x4 g0 = *(const f32x4*)(ng + c), g1 = *(const f32x4*)(ng + c + 4);
            f32x4 o0 = a0 + b0, o1 = a1 + b1;
            float sm = (o0[0] + o0[1] + o0[2] + o0[3]) + (o1[0] + o1[1] + o1[2] + o1[3]);
#pragma unroll
            for (int o = 16; o > 0; o >>= 1) sm += __shfl_xor(sm, o);
            const float mu = sm * (1.f / 256.f);
            o0 = o0 - mu; o1 = o1 - mu;
            float sq = (o0[0] * o0[0] + o0[1] * o0[1] + o0[2] * o0[2] + o0[3] * o0[3]) + (o1[0] * o1[0] + o1[1] * o1[1] + o1[2] * o1[2] + o1[3] * o1[3]);
#pragma unroll
            for (int o = 16; o > 0; o >>= 1) sq += __shfl_xor(sq, o);
            const float rs = rsqrtf(sq * (1.f / 256.f) + 1e-5f);
            float r[8], v[8]; unpack8(rw, r);
#pragma unroll
            for (int j = 0; j < 4; ++j) { v[j] = o0[j] * rs * g0[j] * (r[j] * sigm(r[j])); v[4 + j] = o1[j] * rs * g1[j] * (r[4 + j] * sigm(r[4 + j])); }
            *(u32x4*)(YG + (size_t)row * 1024 + c) = pack8(v); }
    }
    {
        const bf16_t* YSF = (const bf16_t*)(ws + WS_YSF); const bf16_t* YSB = (const bf16_t*)(ws + WS_YSB); bf16_t* YSA = (bf16_t*)(ws + WS_YSA);
        const float* sd = kin(21 + z) + (size_t)l * 1024;
#pragma unroll 2
        for (int i = gt; i < SEG * 128; i += gs) { const int row = i >> 7, c = (i & 127) * 8;
            const u32x4 a = *(const u32x4*)(YSF + (size_t)row * 1024 + c), b = *(const u32x4*)(YSB + (size_t)row * 1024 + c), u = *(const u32x4*)(PROJ + (size_t)row * LDP + CU + c);
            const f32x4 d0 = *(const f32x4*)(sd + c), d1 = *(const f32x4*)(sd + c + 4);
            float fa[8], fb[8], fu[8], v[8]; unpack8(a, fa); unpack8(b, fb); unpack8(u, fu);
#pragma unroll
            for (int j = 0; j < 8; ++j) v[j] = gelu_(fa[j] + fb[j] + (j < 4 ? d0[j] : d1[j - 4]) * fu[j]);
            *(u32x4*)(YSA + (size_t)row * 1024 + c) = pack8(v); }
    }
    {
        const bf16_t* HF = (const bf16_t*)(ws + WS_HF); const bf16_t* HB = (const bf16_t*)(ws + WS_HB); bf16_t* YL = (bf16_t*)(ws + WS_YL);
#pragma unroll 2
        for (int i = gt; i < SEG * 192; i += gs) { const int row = i / 192, c = (i % 192) * 8;
            const u32x4 a = *(const u32x4*)(HF + (size_t)row * 1536 + c), b = *(const u32x4*)(HB + (size_t)row * 1536 + c), y = *(const u32x4*)(PROJ + (size_t)row * LDP + CLY + c);
            float fa[8], fb[8], fy[8], v[8]; unpack8(a, fa); unpack8(b, fb); unpack8(y, fy);
#pragma unroll
            for (int j = 0; j < 8; ++j) v[j] = (fa[j] + fb[j]) * gelu_(fy[j]);
            *(u32x4*)(YL + (size_t)row * 1536 + c) = pack8(v); }
    }
}

__device__ __forceinline__ void phase_ln(const Params& p, int seg, int nrows, bool two, const float* g, const float* b, const float* modl  , int shift_off, int scale_off, bf16_t* hdst  ) {
    const int z = ozero();
    const int lane = otid() & 63, wv = obid() * 8 + (otid() >> 6), nw = gridDim.x * 8;
    const float* PRE = (const float*)(((unsigned char*)kin(41 + z)) + WS_PRE);
    float* X = ((float*)kin(40 + z)) + (size_t)seg * SEG * 1024;
    for (int row0 = wv * 2; row0 < nrows; row0 += nw * 2) {
        f32x4 v[2][4];
#pragma unroll
        for (int rr = 0; rr < 2; ++rr)
#pragma unroll
            for (int q = 0; q < 4; ++q) { v[rr][q] = *(const f32x4*)(PRE + (size_t)(row0 + rr) * 1024 + q * 256 + lane * 4); if (two) v[rr][q] += *(const f32x4*)(PRE + (size_t)SEG * 1024 + (size_t)(row0 + rr) * 1024 + q * 256 + lane * 4); }
#pragma unroll
        for (int rr = 0; rr < 2; ++rr) { const int row = row0 + rr; float s = 0.f;
#pragma unroll
            for (int q = 0; q < 4; ++q) s += v[rr][q][0] + v[rr][q][1] + v[rr][q][2] + v[rr][q][3];
            const float mu = wsum(s) * (1.f / 1024.f); float ss = 0.f;
#pragma unroll
            for (int q = 0; q < 4; ++q) { v[rr][q] = v[rr][q] - mu; ss += v[rr][q][0] * v[rr][q][0] + v[rr][q][1] * v[rr][q][1] + v[rr][q][2] * v[rr][q][2] + v[rr][q][3] * v[rr][q][3]; }
            const float rs = rsqrtf(wsum(ss) * (1.f / 1024.f) + 1e-5f);
            const float* mp = modl ? modl + (size_t)modrow_of(seg, row) * 6144 : nullptr;
#pragma unroll
            for (int q = 0; q < 4; ++q) { const int c = q * 256 + lane * 4;
                const f32x4 y = v[rr][q] * rs * *(const f32x4*)(g + c) + *(const f32x4*)(b + c);
                *(f32x4*)(X + (size_t)row * 1024 + c) = y;
                if (mp) { const f32x4 sh = *(const f32x4*)(mp + shift_off + c), sc = *(const f32x4*)(mp + scale_off + c);
                    u32x2 w; w.x = pk2(y[0] * (1.f + sc[0]) + sh[0], y[1] * (1.f + sc[1]) + sh[1]); w.y = pk2(y[2] * (1.f + sc[2]) + sh[2], y[3] * (1.f + sc[3]) + sh[3]);
                    *(u32x2*)(hdst + (size_t)row * 1024 + c) = w; } } }
    }
}

__device__ __forceinline__ void phase_mconv(const Params& p, int seg) {
    const int z = ozero();
    unsigned char* ws = (unsigned char*)kin(41 + z);
    const float* M1 = (const float*)(ws + WS_MRG); const float* M2 = (const float*)(ws + WS_MRG2); bf16_t* MG = (bf16_t*)(ws + WS_MG2) + (size_t)(seg & 1) * SEG * 1024;
    const int gs = gridDim.x * 512;
#pragma unroll 2
    for (int i = obid() * 512 + otid(); i < SEG * 128; i += gs) { const size_t o = (size_t)i * 8;
        const f32x4 a0 = *(const f32x4*)(M1 + o), a1 = *(const f32x4*)(M1 + o + 4), b0 = *(const f32x4*)(M2 + o), b1 = *(const f32x4*)(M2 + o + 4);
        float v[8];
#pragma unroll
        for (int j = 0; j < 4; ++j) { v[j] = a0[j] + b0[j]; v[4 + j] = a1[j] + b1[j]; }
        *(u32x4*)(MG + o) = pack8(v); }
}

#define XB_TMO      128
#define XB_XCNT(j)  (256  + 64 * (j))
#define XB_XSUB(j)  (1280 + 64 * (j))
#define XB_XGEN(j)  (2304 + 64 * (j))
#define XB_TOP      3328
#define XB_TOPGEN   3392
#define XCD_BAR_WORDS 3456
#define XB_SPIN_CAP (1u << 20)
__device__ __forceinline__ unsigned xb_ld(unsigned* p)              { return __hip_atomic_load(p, __ATOMIC_RELAXED, __HIP_MEMORY_SCOPE_AGENT); }
__device__ __forceinline__ unsigned xb_add(unsigned* p, unsigned v) { return __hip_atomic_fetch_add(p, v, __ATOMIC_RELAXED, __HIP_MEMORY_SCOPE_AGENT); }
__device__ __forceinline__ unsigned xb_xcc_id() { return (unsigned)__builtin_amdgcn_s_getreg((3 << 11) | 20) & 0xFu; }
#define XB_SPIN(cond, bar) do { unsigned _sp = 0; while (cond) { __builtin_amdgcn_s_sleep(1); \
    if ((++_sp & 255u) == 0u) { if (xb_ld(&(bar)[XB_TMO])) break; if (_sp > XB_SPIN_CAP) { atomicAdd(&(bar)[XB_TMO], 1u); break; } } } } while (0)
struct XcdBarrier { unsigned* bar; unsigned x; volatile LAS unsigned* st; };
__device__ __forceinline__ XcdBarrier xcd_barrier_post(unsigned* bar, volatile LAS unsigned* st) {
    XcdBarrier b; b.bar = bar; b.x = xb_xcc_id(); b.st = st;
    if (threadIdx.x == 0) (void)xb_add(&bar[XB_XCNT(b.x)], 1u);
    return b;
}
__device__ __forceinline__ void xcd_barrier_complete(unsigned* bar, unsigned x, unsigned& nloc, unsigned& nx) {
    const unsigned G = gridDim.x * gridDim.y * gridDim.z;
    unsigned sum, cnt, mine, sp = 0u;
    for (;;) {
        sum = 0u; cnt = 0u; mine = 0u;
#pragma unroll
        for (unsigned j = 0; j < 16; ++j) { const unsigned c = xb_ld(&bar[XB_XCNT(j)]); sum += c; cnt += (c > 0u) ? 1u : 0u; mine = (j == x) ? c : mine; }
        if (sum == G) break;
        __builtin_amdgcn_s_sleep(1);
        if ((++sp & 255u) == 0u) { if (xb_ld(&bar[XB_TMO])) break; if (sp > XB_SPIN_CAP) { atomicAdd(&bar[XB_TMO], 1u); break; } }
    }
    nloc = mine > 0u ? mine : 1u; nx = cnt > 0u ? cnt : 1u;
}
__device__ __forceinline__ void xcd_barrier(const XcdBarrier& b) {
    asm volatile("s_waitcnt vmcnt(0)" ::: "memory");
    __syncthreads();
    if (threadIdx.x == 0) {
        unsigned* bar = b.bar;
        __builtin_amdgcn_s_waitcnt(0);
        unsigned nloc = b.st[0], nx = b.st[1];
        if (nloc == 0u) { xcd_barrier_complete(bar, b.x, nloc, nx); b.st[0] = nloc; b.st[1] = nx; }
        const unsigned old = xb_add(&bar[XB_XSUB(b.x)], 1u);
        const unsigned gen = old / nloc;
        if (old + 1u == (gen + 1u) * nloc) {
            __builtin_amdgcn_fence(__ATOMIC_RELEASE, "agent");
            asm volatile("s_waitcnt vmcnt(0)" ::: "memory");
            const unsigned og = xb_add(&bar[XB_TOP], 1u);
            const unsigned tg = og / nx;
            if (og + 1u == (tg + 1u) * nx) xb_add(&bar[XB_TOPGEN], 1u);
            else XB_SPIN(xb_ld(&bar[XB_TOPGEN]) == tg, bar);
            __builtin_amdgcn_fence(__ATOMIC_ACQUIRE, "agent");
            xb_add(&bar[XB_XGEN(b.x)], 1u);
            asm volatile("s_waitcnt vmcnt(0)" ::: "memory");
        } else {
            XB_SPIN(xb_ld(&bar[XB_XGEN(b.x)]) == gen, bar);
            __builtin_amdgcn_fence(__ATOMIC_ACQUIRE, "agent");
            asm volatile("s_waitcnt vmcnt(0)" ::: "memory");
        }
    }
    __syncthreads();
}

__global__ void __launch_bounds__(512, 2) fwd_megakernel(Params p) {
    extern __shared__ __attribute__((aligned(16))) unsigned char lds[];
    cg::grid_group grid = cg::this_grid();
    volatile LAS unsigned* xst = (volatile LAS unsigned*)(lds + 131072);
    if (threadIdx.x == 0) { xst[0] = 0u; xst[1] = 0u; }
    __syncthreads();
    XcdBarrier xb = xcd_barrier_post((unsigned*)(p.ws + WS_BAR), xst);
    phase_mods(p, lds);
    grid.sync();
    phase_xinit(p);
    for (int l = 0; l < 4; ++l) {
        phase_layer_setup(p, l, lds);
        xcd_barrier(xb);
        for (int seg = 0; seg < NSEG; ++seg) {
            const int z = ozero();
            unsigned char* ws = (unsigned char*)kin(41 + z);
            const float* modl = (const float*)(ws + WS_MOD) + (size_t)l * 9 * 6144;
            { EpiProj E; E.O = (bf16_t*)(ws + WS_PROJ); E.col_off = 0;
                run_gemm(lds, (const bf16_t*)(ws + WS_HA) + (size_t)seg * SEG * 1024, 1024, (const bf16_t*)(ws + WS_WIN), 1024, SEG, 10240, 1024, 1, 0, E); }
            xcd_barrier(xb);
            if (seg & 1) phase_mconv(p, seg - 1);
            phase_conv(p, l, seg);
            if ((obid() & 7) == 7) {
                EpiProj E; E.O = (bf16_t*)(ws + WS_PROJ); E.col_off = CGLR;
                run_gemm_sub(lds, (const bf16_t*)(ws + WS_HA) + (size_t)seg * SEG * 1024, 1024, (const bf16_t*)(ws + WS_WIN) + (size_t)CGLR * 1024, 1024, SEG, 256, 1024, (int)gridDim.x >> 3, obid() >> 3, E);
            } else s5_items(p, l, seg, 1, lds);
            xcd_barrier(xb);
            { EpiLruGate E; E.XC = (const bf16_t*)(ws + WS_XC); E.LAB = (unsigned*)(ws + WS_LAB); E.cl = (const float*)(ws + WS_LCL); E.ba = kin(26 + z) + (size_t)l * 3072; E.bi = kin(28 + z) + (size_t)l * 3072;
                run_gemm(lds, (const bf16_t*)(ws + WS_XC), 1536, (const bf16_t*)(ws + WS_WLRU), 256, SEG, 6144, 256, 12, 512, E); }
            xcd_barrier(xb);
            if (seg != 0) {
                gla_items(p, l, seg, 1, lds);
                s5_items(p, l, seg, 2, lds);
                lru_scan(p, l, seg, 1);
                xcd_barrier(xb);
            }
            gla_items(p, l, seg, 2, lds);
            if (seg == 0) s5_items(p, l, seg, 2, lds);
            lru_scan(p, l, seg, 2);
            xcd_barrier(xb);
            phase_post(p, l);
            xcd_barrier(xb);
            { const int bid = obid(), half = (int)gridDim.x >> 1;
                if (bid < half) { EpiGlu E; E.YSA = (const bf16_t*)(ws + WS_YSA); E.YS5 = (bf16_t*)(ws + WS_YS5);
                    run_gemm_sub(lds, (const bf16_t*)(ws + WS_YSA), 1024, (const bf16_t*)(ws + WS_WGLU), 1024, SEG, 1024, 1024, half, bid, E); }
                else { EpiMerge E; E.MRG = (float*)(ws + WS_MRG); E.MERGED = nullptr; E.mode = 0; E.G = (const bf16_t*)(ws + WS_PROJ) + CG;
                    run_gemm_sub(lds, (const bf16_t*)(ws + WS_YG), 1024, (const bf16_t*)(ws + WS_WBG), 1024, SEG, 1024, 1024, (int)gridDim.x - half, bid - half, E); } }
            xcd_barrier(xb);
            { const int bid = obid(), half = (int)gridDim.x >> 1;
                if (bid < half) { EpiMerge E; E.MRG = (float*)(ws + WS_MRG2); E.MERGED = nullptr; E.mode = 0; E.G = (const bf16_t*)(ws + WS_PROJ) + CG + 1024;
                    run_gemm_sub(lds, (const bf16_t*)(ws + WS_YS5), 1024, (const bf16_t*)(ws + WS_WBS), 1024, SEG, 1024, 1024, half, bid, E); }
                else { EpiMerge E; E.MRG = (float*)(ws + WS_MRG); E.MERGED = nullptr; E.mode = 1; E.G = (const bf16_t*)(ws + WS_PROJ) + CG + 2048;
                    run_gemm_sub(lds, (const bf16_t*)(ws + WS_YL), 1536, (const bf16_t*)(ws + WS_WBL), 1536, SEG, 1024, 1536, (int)gridDim.x - half, bid - half, E); } }
            xcd_barrier(xb);
            if ((seg & 1) || seg == NSEG - 1) {
                phase_mconv(p, seg);
                xcd_barrier(xb);
            }
            if ((seg & 1) || seg == NSEG - 1) {
                const int g0 = seg & ~1, M = (seg - g0 + 1) * SEG;
                const bool lone = (M == SEG);
                const int bid = obid(), half = (int)gridDim.x >> 1;
                if (!lone) { EpiRes E; E.X = (const float*)kin(40 + z) + (size_t)g0 * SEG * 1024; E.gate = modl + 2048; E.seg = g0; E.PRE = (float*)(ws + WS_PRE); E.xs = ALPHA;
                    run_gemm(lds, (const bf16_t*)(ws + WS_MG2), 1024, (const bf16_t*)(ws + WS_WOUT), 1024, M, 1024, 1024, 1, 0, E); }
                else { const int hi = bid >= half ? 1 : 0; EpiRes E; E.X = (const float*)kin(40 + z) + (size_t)g0 * SEG * 1024; E.gate = modl + 2048; E.seg = g0; E.PRE = (float*)(ws + WS_PRE) + (size_t)hi * SEG * 1024; E.xs = hi ? 0.f : ALPHA;
                    run_gemm_sub(lds, (const bf16_t*)(ws + WS_MG2) + hi * 512, 1024, (const bf16_t*)(ws + WS_WOUT) + hi * 512, 1024, M, 1024, 512, hi ? (int)gridDim.x - half : half, hi ? bid - half : bid, E); }
                xcd_barrier(xb);
                phase_ln(p, g0, M, lone, kin(34 + z) + (size_t)l * 1024, kin(35 + z) + (size_t)l * 1024, modl, 3072, 4096, (bf16_t*)(ws + WS_H2));
                xcd_barrier(xb);
                { EpiRelu2 E; E.O = (bf16_t*)(ws + WS_HID);
                    run_gemm(lds, (const bf16_t*)(ws + WS_H2), 1024, (const bf16_t*)(ws + WS_WMI), 1024, M, 4096, 1024, 1, 0, E); }
                xcd_barrier(xb);
                if (!lone) { EpiRes E; E.X = (const float*)kin(40 + z) + (size_t)g0 * SEG * 1024; E.gate = modl + 5120; E.seg = g0; E.PRE = (float*)(ws + WS_PRE); E.xs = ALPHA;
                    run_gemm(lds, (const bf16_t*)(ws + WS_HID), 4096, (const bf16_t*)(ws + WS_WMO), 4096, M, 1024, 4096, 1, 0, E); }
                else { const int hi = bid >= half ? 1 : 0; EpiRes E; E.X = (const float*)kin(40 + z) + (size_t)g0 * SEG * 1024; E.gate = modl + 5120; E.seg = g0; E.PRE = (float*)(ws + WS_PRE) + (size_t)hi * SEG * 1024; E.xs = hi ? 0.f : ALPHA;
                    run_gemm_sub(lds, (const bf16_t*)(ws + WS_HID) + hi * 2048, 4096, (const bf16_t*)(ws + WS_WMO) + hi * 2048, 4096, M, 1024, 2048, hi ? (int)gridDim.x - half : half, hi ? bid - half : bid, E); }
                xcd_barrier(xb);
                phase_ln(p, g0, M, lone, kin(36 + z) + (size_t)l * 1024, kin(37 + z) + (size_t)l * 1024, l < 3 ? modl + 9 * 6144 : nullptr, 0, 1024, (bf16_t*)(ws + WS_HA) + (size_t)g0 * SEG * 1024);
            }
        }
    }
}

extern "C" void kernel_launch(void* const* d_in, const int* in_sizes, int n_in, void* d_out, int out_size, void* d_ws, size_t ws_size, hipStream_t stream) {
    constexpr int kLds = 131072 + 16;
    static int grid_blocks = 0;
    if (grid_blocks == 0) {
        if (n_in != 40 || ws_size < WS_END) { fprintf(stderr, "kernel_launch: n_in %d ws %zu need %zu\n", n_in, ws_size, (size_t)WS_END); grid_blocks = -1; return; }
        int dev = 0, cus = 0, per_cu = 0;
        hipGetDevice(&dev);
        hipDeviceGetAttribute(&cus, hipDeviceAttributeMultiprocessorCount, dev);
        hipFuncSetAttribute((const void*)fwd_megakernel, hipFuncAttributeMaxDynamicSharedMemorySize, kLds);
        hipOccupancyMaxActiveBlocksPerMultiprocessor(&per_cu, (const void*)fwd_megakernel, 512, kLds);
        if (per_cu < 1) per_cu = 1;
        grid_blocks = cus * per_cu;
        if (grid_blocks > 256) grid_blocks = 256;
    }
    if (grid_blocks < 0) return;
    Params p{};
    for (int i = 0; i < 40; ++i) p.in[i] = (const float*)d_in[i];
    p.out = (float*)d_out; p.ws = (unsigned char*)d_ws;
    (void)hipMemsetAsync((unsigned char*)d_ws + WS_BAR, 0, 16384, stream);
    void* args[] = {&p};
    hipError_t e = hipLaunchCooperativeKernel((const void*)fwd_megakernel, dim3(grid_blocks), dim3(512), args, kLds, stream);
    if (e != hipSuccess) fprintf(stderr, "cooperative launch failed: %s (grid %d)\n", hipGetErrorString(e), grid_blocks);
}
```
